# Optimizing an MI355X kernel written in HIP

```python
import jax, jax.numpy as jnp
from jax import lax
import numpy as np

D_MODEL = 1024
BATCH = 2
SEQ = 8192
DEPTH = 2

N_MIXERS = 2
N_FOX = (DEPTH + 1) // 2
N_HGRN = DEPTH // 2
FOX_HEADS = 16
FOX_HEAD_DIM = D_MODEL // FOX_HEADS
FOX_BLOCK_Q = 128
HGRN_EXPAND = 128
HGRN_HEADS = D_MODEL // HGRN_EXPAND
HGRN_CHUNK = 64
D_FF = ((8 * D_MODEL // 3 + 127) // 128) * 128
N_SUB = 3
EPS = 1e-6

kernel_name = "fox_hgrn2_macaron_adaln_hybrid"


def _normal(k, shape, scale):
    return jax.random.normal(k, shape, jnp.float32) * scale


def setup_inputs(seed: int = 0) -> dict:
    key = jax.random.key(seed)
    ks = jax.random.split(key, 16)
    D, F = D_MODEL, D_FF
    return {
        "x": _normal(ks[0], (BATCH, SEQ, D), 1.0),
        "c": _normal(ks[1], (BATCH, D), 1.0),
        "ada_w": _normal(ks[2], (DEPTH, D, N_SUB * 3 * D), D ** -0.5),
        "ada_b": _normal(ks[3], (DEPTH, N_SUB * 3 * D), 0.02),
        "norm_g": 1.0 + _normal(ks[4], (DEPTH, N_SUB, D), 0.02),
        "ffn_w_up": _normal(ks[5], (DEPTH, 2, D, 2 * F), D ** -0.5),
        "ffn_w_down": _normal(ks[6], (DEPTH, 2, F, D), F ** -0.5),
        "fox_w_in": _normal(ks[7], (N_FOX, D, 4 * D + FOX_HEADS), D ** -0.5),
        "fox_b_f": 2.0 + _normal(ks[8], (N_FOX, FOX_HEADS), 0.5),
        "fox_w_out": _normal(ks[9], (N_FOX, D, D), D ** -0.5),
        "hgrn_w_in": _normal(ks[10], (N_HGRN, D, 4 * D), D ** -0.5),
        "hgrn_norm_g": 1.0 + _normal(ks[11], (N_HGRN, D), 0.02),
        "hgrn_w_out": _normal(ks[12], (N_HGRN, D, D), D ** -0.5),
        "hgrn_lb_logits": _normal(ks[13], (DEPTH, D), 0.5),
        "final_norm_g": 1.0 + _normal(ks[14], (D,), 0.02),
    }


def rms_norm(x, g):
    xf = x.astype(jnp.float32)
    y = xf * lax.rsqrt(jnp.mean(xf * xf, axis=-1, keepdims=True) + EPS)
    return (y * g.astype(jnp.float32)).astype(x.dtype)


def swiglu(h, w_up, w_down):
    a, b = jnp.split(h @ w_up, 2, axis=-1)
    return (jax.nn.silu(a) * b) @ w_down


def fox_attention(h, w_in, b_f, w_out):
    B, S, D = h.shape
    H, Dh, BQ = FOX_HEADS, FOX_HEAD_DIM, FOX_BLOCK_Q
    proj = h @ w_in
    heads = lambda t: t.reshape(B, S, H, Dh).transpose(0, 2, 1, 3)
    q = heads(proj[..., 0:D])
    k = heads(proj[..., D:2 * D])
    v = heads(proj[..., 2 * D:3 * D])
    g = proj[..., 3 * D:4 * D]
    logf = jax.nn.log_sigmoid((proj[..., 4 * D:] + b_f).astype(jnp.float32))
    cum = jnp.cumsum(logf, axis=1).transpose(0, 2, 1)
    nb = S // BQ
    q_blocks = q.reshape(B, H, nb, BQ, Dh).transpose(2, 0, 1, 3, 4)
    c_blocks = cum.reshape(B, H, nb, BQ).transpose(2, 0, 1, 3)
    k_pos = jnp.arange(S)
    scale = Dh ** -0.5

    def block(args):
        qb, cb, start = args
        s = (jnp.einsum('bhqd,bhkd->bhqk', qb, k).astype(jnp.float32) * scale
             + cb[..., None] - cum[:, :, None, :])
        q_pos = start + jnp.arange(BQ)
        s = jnp.where(k_pos[None, :] <= q_pos[:, None], s, -jnp.inf)
        p = jax.nn.softmax(s, axis=-1)
        return jnp.einsum('bhqk,bhkd->bhqd', p.astype(v.dtype), v)

    o = lax.map(block, (q_blocks, c_blocks, jnp.arange(nb) * BQ))
    o = o.transpose(1, 0, 3, 2, 4).reshape(B, S, D)
    o = o * jax.nn.sigmoid(g)
    return o @ w_out


def hgrn2(h, w_in, lb, g_norm, w_out):
    B, S, D = h.shape
    H, K, C = HGRN_HEADS, HGRN_EXPAND, HGRN_CHUNK
    nc = S // C
    proj = (h @ w_in).astype(jnp.float32)
    q = proj[..., 0:D]
    f = lb + (1.0 - lb) * jax.nn.sigmoid(proj[..., D:2 * D])
    v = jax.nn.silu(proj[..., 2 * D:3 * D])
    g = proj[..., 3 * D:4 * D]
    logf = jnp.log(f)
    k = 1.0 - f
    to_chunks = lambda t: t.reshape(B, nc, C, H, K).transpose(1, 0, 3, 2, 4)
    tri = jnp.tril(jnp.ones((C, C), dtype=bool))

    def step(state, inp):
        qc, kc, vc, gc = inp
        G = jnp.cumsum(gc, axis=2)
        o_inter = jnp.einsum('bhtk,bhkv->bhtv', qc * jnp.exp(G), state)
        diff = G[:, :, :, None, :] - G[:, :, None, :, :]
        decay = jnp.exp(jnp.where(tri[:, :, None], diff, -jnp.inf))
        A = jnp.einsum('bhtk,bhsk,bhtsk->bhts', qc, kc, decay)
        o_intra = jnp.einsum('bhts,bhsv->bhtv', A, vc)
        G_last = G[:, :, -1, :]
        state = (jnp.exp(G_last)[..., None] * state
                 + jnp.einsum('bhsk,bhsv->bhkv', kc * jnp.exp(G_last[:, :, None, :] - G), vc))
        return state, o_inter + o_intra

    state0 = jnp.zeros((B, H, K, K), jnp.float32)
    _, o = lax.scan(step, state0, (to_chunks(q), to_chunks(k), to_chunks(v), to_chunks(logf)))
    o = o.transpose(1, 0, 3, 2, 4)
    o = o * lax.rsqrt(jnp.mean(o * o, axis=-1, keepdims=True) + EPS)
    o = o * g_norm.astype(jnp.float32).reshape(H, K)
    o = o.reshape(B, S, D) * jax.nn.silu(g)
    return o.astype(h.dtype) @ w_out


def reference(x, c, ada_w, ada_b, norm_g, ffn_w_up, ffn_w_down, fox_w_in, fox_b_f,
              fox_w_out, hgrn_w_in, hgrn_norm_g, hgrn_w_out, hgrn_lb_logits, final_norm_g):
    B, S, D = x.shape
    cond = jax.nn.silu(c)
    sm = jax.nn.softmax(hgrn_lb_logits.astype(jnp.float32), axis=0)
    lower_bounds = jnp.cumsum(sm, axis=0) - sm[0]
    for i in range(DEPTH):
        mod = (cond @ ada_w[i] + ada_b[i]).reshape(B, N_SUB, 3, 1, D)
        h = rms_norm(x, norm_g[i, 0]) * (1.0 + mod[:, 0, 1]) + mod[:, 0, 0]
        x = x + 0.5 * mod[:, 0, 2] * swiglu(h, ffn_w_up[i, 0], ffn_w_down[i, 0])
        h = rms_norm(x, norm_g[i, 1]) * (1.0 + mod[:, 1, 1]) + mod[:, 1, 0]
        j = i // N_MIXERS
        if i % N_MIXERS == 0:
            y = fox_attention(h, fox_w_in[j], fox_b_f[j], fox_w_out[j])
        else:
            y = hgrn2(h, hgrn_w_in[j], lower_bounds[i], hgrn_norm_g[j], hgrn_w_out[j])
        x = x + mod[:, 1, 2] * y
        h = rms_norm(x, norm_g[i, 2]) * (1.0 + mod[:, 2, 1]) + mod[:, 2, 0]
        x = x + 0.5 * mod[:, 2, 2] * swiglu(h, ffn_w_up[i, 1], ffn_w_down[i, 1])
    return rms_norm(x, final_norm_g)
```

```cpp
#include <hip/hip_runtime.h>
#include <cstdio>
#include <cstdint>
namespace pg8 {
#define PG8_LAS __attribute__((address_space(3)))
typedef unsigned short bf16_t;
typedef short bf16x8 __attribute__((ext_vector_type(8)));
typedef float f32x4 __attribute__((ext_vector_type(4)));
typedef unsigned u32x4 __attribute__((ext_vector_type(4)));
constexpr int BM = 256, BK = 64, HALF = 128, HTB = HALF * BK * 2  , STAGE_BYTES = 8 * HTB, NXCD = 8, WGM = 8;

__host__ __device__ __forceinline__ int lds_byte(int r, int c) { const int st = (r >> 4) * 2 + (c >> 5), rr = r & 15, cc = c & 31, ob = rr * 64 + cc * 2; return st * 1024 + (ob ^ (((ob >> 9) & 1) << 5)); }
__host__ __device__ __forceinline__ void stage_rc(int b, int& R, int& C) { const int st = b / 1024, sb = b % 1024, swz = sb ^ (((sb >> 9) & 1) << 5); R = (st >> 1) * 16 + swz / 64; C = (st & 1) * 32 + (swz % 64) / 2; }
__host__ __device__ __forceinline__ int perm32(int rho) { const int n = rho >> 4, i = rho & 15; return 8 * (i >> 2) + 4 * n + (i & 3); }

struct Unit { int pm, pn; };
struct Gemm { const bf16_t* A; const bf16_t* Bt; int M, N, K; };

struct StaticOrder {
    int nM, nN, nwg, G, c;
    __host__ __device__ void init(int M, int N, int G_, int c_) { nM = M / BM; nN = N / BM; nwg = nM * nN; G = G_; c = c_; }
    __host__ __device__ bool next(int i, Unit& u) const {
        const long L = (long)i * G + c; if (L >= nwg) return false;
        int wgid = (int)L; { const int q = nwg / NXCD, r = nwg % NXCD, xcd = wgid % NXCD, off = wgid / NXCD; wgid = (xcd < r ? xcd * (q + 1) : r * (q + 1) + (xcd - r) * q) + off; }
        const int nig = WGM * nN, gid = wgid / nig, fm = gid * WGM, gsz = (nM - fm) < WGM ? (nM - fm) : WGM;
        u.pm = fm + ((wgid % nig) % gsz); u.pn = (wgid % nig) / gsz; return true;
    }
    __device__ __forceinline__ void a_ready(const Unit&) const {}
    __device__ __forceinline__ void done(const Unit&) const {}
};

__device__ __forceinline__ unsigned cvt_pk_bf16(float lo, float hi) { unsigned r; asm volatile("v_cvt_pk_bf16_f32 %0, %1, %2" : "=v"(r) : "v"(lo), "v"(hi)); return r; }
typedef float f32x2 __attribute__((ext_vector_type(2)));
__device__ __forceinline__ float sigmoid_f(float z) { return __builtin_amdgcn_rcpf(1.0f + __builtin_amdgcn_exp2f(-1.4426950408889634f * z)); }
__device__ __forceinline__ float silu_f(float z) { return z * sigmoid_f(z); }

struct EpiSwiGLU {
    static constexpr bool PERM = true, AFTER_DRAIN = false;
    bf16_t* O; int ldc;
    __device__ __forceinline__ void operator()(const f32x4 (&acc)[2][2][4][2], const Unit& u, int wr, int wc, int fr, int fq) const {
        const int row0 = u.pm * BM + wr * 64 + fr, col0 = u.pn * HALF + wc * 32 + 8 * fq;
#pragma unroll
        for (int ai = 0; ai < 2; ++ai)
#pragma unroll
            for (int m = 0; m < 4; ++m) { bf16_t* rowp = O + (size_t)(row0 + ai * HALF + m * 16) * ldc + col0;
                f32x4 v0, v1;
#pragma unroll
                for (int e = 0; e < 4; ++e) { v0[e] = silu_f(acc[ai][0][m][0][e]) * acc[ai][1][m][0][e]; v1[e] = silu_f(acc[ai][0][m][1][e]) * acc[ai][1][m][1][e]; }
                u32x4 w; w.x = cvt_pk_bf16(v0[0], v0[1]); w.y = cvt_pk_bf16(v0[2], v0[3]); w.z = cvt_pk_bf16(v1[0], v1[1]); w.w = cvt_pk_bf16(v1[2], v1[3]);
                *(u32x4*)rowp = w; asm volatile("" ::: "memory"); }
    }
};

struct EpiResGate {
    static constexpr bool PERM = false, AFTER_DRAIN = false;
    const float* base; float* out; int ldc; const float* gate0; const float* gate1; float coef;
    __device__ __forceinline__ void operator()(const f32x4 (&acc)[2][2][4][2], const Unit& u, int wr, int wc, int fr, int fq) const {
        const float* gp = (u.pm >= 32) ? gate1 : gate0;
        const int col0 = u.pn * BM + wc * 32 + 4 * fq;
#pragma unroll
        for (int ai = 0; ai < 2; ++ai)
#pragma unroll
            for (int m = 0; m < 4; ++m) { const size_t off = (size_t)(u.pm * BM + ai * HALF + wr * 64 + m * 16 + fr) * ldc + col0;
#pragma unroll
                for (int bj = 0; bj < 2; ++bj)
#pragma unroll
                    for (int n = 0; n < 2; ++n) { const f32x4 gv = *(const f32x4*)(gp + col0 + bj * HALF + n * 16) * coef; const f32x4 bs = *(const f32x4*)(base + off + bj * HALF + n * 16); *(f32x4*)(out + off + bj * HALF + n * 16) = bs + acc[ai][bj][m][n] * gv; }
                asm volatile("" ::: "memory"); }
    }
};

template <int MODE> struct EpiSplit4 {
    static constexpr bool PERM = true, AFTER_DRAIN = false;
    bf16_t* O0; size_t ostride; float* F1; const float* lb; float scale0;
    __device__ __forceinline__ void operator()(const f32x4 (&acc)[2][2][4][2], const Unit& u, int wr, int wc, int fr, int fq) const {
        const int t = u.pn >> 2, row0 = u.pm * BM + wr * 64 + fr, col0 = (u.pn & 3) * BM + wc * 32 + 8 * fq;
        bf16_t* Ob = O0 + (size_t)t * ostride;
        if (MODE == 1 && t == 1) {
#pragma unroll
            for (int ai = 0; ai < 2; ++ai)
#pragma unroll
                for (int m = 0; m < 4; ++m) { float* rowp = F1 + (size_t)(row0 + ai * HALF + m * 16) * 1024 + col0;
#pragma unroll
                    for (int bj = 0; bj < 2; ++bj)
#pragma unroll
                        for (int n = 0; n < 2; ++n) { f32x4 o; const f32x4 lbv = *(const f32x4*)(lb + col0 + bj * HALF + 4 * n);
#pragma unroll
                            for (int e = 0; e < 4; ++e) { const float l = lbv[e]; o[e] = __logf(l + (1.0f - l) * sigmoid_f(acc[ai][bj][m][n][e])); }
                            *(f32x4*)(rowp + bj * HALF + 4 * n) = o; }
                    asm volatile("" ::: "memory"); }
            return;
        }
        const int act = (MODE == 0) ? (t == 3 ? 1 : 0) : (t >= 2 ? 2 : 0);
        const float sc = (MODE == 0 && t == 0) ? scale0 : 1.0f;
#pragma unroll
        for (int ai = 0; ai < 2; ++ai)
#pragma unroll
            for (int m = 0; m < 4; ++m) { bf16_t* rowp = Ob + (size_t)(row0 + ai * HALF + m * 16) * 1024 + col0;
#pragma unroll
                for (int bj = 0; bj < 2; ++bj) { f32x4 v0 = acc[ai][bj][m][0], v1 = acc[ai][bj][m][1];
                    if (act == 1) {
#pragma unroll
                        for (int e = 0; e < 4; ++e) { v0[e] = sigmoid_f(v0[e]); v1[e] = sigmoid_f(v1[e]); } }
                    else if (act == 2) {
#pragma unroll
                        for (int e = 0; e < 4; ++e) { v0[e] = silu_f(v0[e]); v1[e] = silu_f(v1[e]); } }
                    v0 = v0 * sc; v1 = v1 * sc;
                    u32x4 w; w.x = cvt_pk_bf16(v0[0], v0[1]); w.y = cvt_pk_bf16(v0[2], v0[3]); w.z = cvt_pk_bf16(v1[0], v1[1]); w.w = cvt_pk_bf16(v1[2], v1[3]);
                    *(u32x4*)(rowp + bj * HALF) = w; }
                asm volatile("" ::: "memory"); }
    }
};
template <class Epi, class Sched, bool ALIGN_EPI = false, bool SP2 = false>
__device__ __forceinline__ void gemm_phase(PG8_LAS unsigned char* lds, const Gemm g, const Sched& S, const Epi& E) {
    int tid_ = threadIdx.x; asm volatile("" : "+v"(tid_));
    const int tid = tid_, wid = __builtin_amdgcn_readfirstlane(tid >> 6), lane = tid & 63, wr = wid >> 2, wc = wid & 3, fr = lane & 15, fq = lane >> 4;
    const int K = g.K, nt = K / BK;
    unsigned voffA[2], voffB[2];
#pragma unroll
    for (int i = 0; i < 2; ++i) { int R, C; stage_rc(tid * 16 + i * 8192, R, C); const int Rb = Epi::PERM ? ((R & ~31) + perm32(R & 31)) : R;
        voffA[i] = (unsigned)(R * K + C) * 2u; voffB[i] = (unsigned)(Rb * K + C) * 2u; }
    const size_t kstep = (size_t)(BK * 2);
    const size_t hstep = (size_t)HALF * K * 2;
    const size_t tstep = 2 * hstep;
    const unsigned ldsw = (unsigned)wid * 1024u;
    const int aoff = lds_byte(wr * 64 + fr, fq * 8), boff = lds_byte(wc * 32 + fr, fq * 8);
#define PG8_SA(b, h) (((b) * 2 + (h)) * HTB)
#define PG8_SB(b, h) ((4 + (b) * 2 + (h)) * HTB)
#define PG8_STAGE(bufoff, gbase, voff) do { _Pragma("unroll") for (int _i = 0; _i < 2; ++_i) \
        __builtin_amdgcn_global_load_lds((const unsigned*)((const char*)(gbase) + (voff)[_i]), (PG8_LAS unsigned*)(lds + (bufoff) + ldsw + _i * 8192), 16, 0, 0); } while (0)
#define PG8_LDA(dst, b, h) do { _Pragma("unroll") for (int m = 0; m < 4; ++m) _Pragma("unroll") for (int k = 0; k < 2; ++k) dst[m][k] = *(const PG8_LAS bf16x8*)(lds + PG8_SA(b, h) + aoff + m * 2048 + k * 1024); } while (0)
#define PG8_LDB(dst, b, h) do { _Pragma("unroll") for (int n = 0; n < 2; ++n) _Pragma("unroll") for (int k = 0; k < 2; ++k) dst[n][k] = *(const PG8_LAS bf16x8*)(lds + PG8_SB(b, h) + boff + n * 2048 + k * 1024); } while (0)
#define PG8_MMA(ai, bj, At, Bt) do { __builtin_amdgcn_s_setprio(1); _Pragma("unroll") for (int m = 0; m < 4; ++m) _Pragma("unroll") for (int n = 0; n < 2; ++n) _Pragma("unroll") for (int k = 0; k < 2; ++k) \
        acc[ai][bj][m][n] = __builtin_amdgcn_mfma_f32_16x16x32_bf16(Bt[n][k], At[m][k], acc[ai][bj][m][n], 0, 0, 0); __builtin_amdgcn_s_setprio(0); } while (0)
#define PG8_WAIT_V(n) asm volatile("s_waitcnt vmcnt(" #n ")" ::: "memory")
#define PG8_WAIT_L(n) asm volatile("s_waitcnt lgkmcnt(" #n ")" ::: "memory")
#define PG8_BAR __builtin_amdgcn_s_barrier()
#define PG8_SCHED __builtin_amdgcn_sched_barrier(0)
    Unit cur, nxt; int ui = 0;
    if (!S.next(0, cur)) return;
    f32x4 acc[2][2][4][2];
#pragma unroll
    for (int a = 0; a < 2; ++a)
#pragma unroll
        for (int b = 0; b < 2; ++b)
#pragma unroll
            for (int m = 0; m < 4; ++m)
#pragma unroll
                for (int n = 0; n < 2; ++n) acc[a][b][m][n] = (f32x4){0.f, 0.f, 0.f, 0.f};
    bf16x8 At[4][2], B0[2][2], B1[2][2];
    const char* cA = (const char*)g.A + (size_t)cur.pm * tstep; const char* cB = (const char*)g.Bt + (size_t)cur.pn * tstep;
    S.a_ready(cur);
    if constexpr (SP2) {
        PG8_STAGE(PG8_SB(0, 0), cB, voffB); PG8_STAGE(PG8_SB(0, 1), cB + hstep, voffB); PG8_STAGE(PG8_SA(0, 0), cA, voffA); PG8_STAGE(PG8_SA(0, 1), cA + hstep, voffA);
        if (wr == 1) PG8_BAR;
        PG8_WAIT_V(2); PG8_BAR;
        PG8_STAGE(PG8_SB(1, 0), cB + kstep, voffB); PG8_STAGE(PG8_SA(1, 0), cA + kstep, voffA); PG8_STAGE(PG8_SB(1, 1), cB + hstep + kstep, voffB);
        PG8_WAIT_V(6); PG8_BAR;
    } else {
        PG8_STAGE(PG8_SB(0, 0), cB, voffB); PG8_STAGE(PG8_SA(0, 0), cA, voffA); PG8_STAGE(PG8_SB(0, 1), cB + hstep, voffB); PG8_STAGE(PG8_SA(0, 1), cA + hstep, voffA);
        if (wr == 1) PG8_BAR;
        PG8_WAIT_V(4); PG8_BAR;
        PG8_STAGE(PG8_SB(1, 0), cB + kstep, voffB); PG8_STAGE(PG8_SA(1, 0), cA + kstep, voffA); PG8_STAGE(PG8_SB(1, 1), cB + hstep + kstep, voffB);
        PG8_WAIT_V(6); PG8_BAR;
    }
    for (;;) {
        const bool has_next = S.next(ui + 1, nxt);
        const char* nA = has_next ? (const char*)g.A + (size_t)nxt.pm * tstep : cA; const char* nB = has_next ? (const char*)g.Bt + (size_t)nxt.pn * tstep : cB;
        for (int t = 0; t < nt; t += 2) {
            const bool last = (t == nt - 2);
            const char* a1 = cA + (size_t)(t + 1) * kstep;
            const char* a2 = last ? nA : cA + (size_t)(t + 2) * kstep; const char* b2 = last ? nB : cB + (size_t)(t + 2) * kstep;
            const char* a3 = a2 + kstep; const char* b3 = b2 + kstep;
            if (last && has_next) S.a_ready(nxt);
            if constexpr (SP2) {
            PG8_LDB(B0, 0, 0); PG8_LDB(B1, 0, 1); PG8_SCHED; PG8_LDA(At, 0, 0); PG8_STAGE(PG8_SA(1, 1), a1 + hstep, voffA);
            PG8_WAIT_V(8); PG8_WAIT_L(0); PG8_BAR; PG8_MMA(0, 0, At, B0); PG8_MMA(0, 1, At, B1); PG8_BAR; PG8_SCHED;
            PG8_LDA(At, 0, 1); PG8_STAGE(PG8_SB(0, 0), b2, voffB); PG8_STAGE(PG8_SB(0, 1), b2 + hstep, voffB); PG8_STAGE(PG8_SA(0, 0), a2, voffA);
            PG8_WAIT_V(8); PG8_WAIT_L(0); PG8_BAR; PG8_MMA(1, 0, At, B0); PG8_MMA(1, 1, At, B1); PG8_BAR; PG8_SCHED;
            PG8_LDB(B0, 1, 0); PG8_LDB(B1, 1, 1); PG8_SCHED; PG8_LDA(At, 1, 0); PG8_STAGE(PG8_SA(0, 1), a2 + hstep, voffA);
            PG8_WAIT_V(8); PG8_WAIT_L(0); PG8_BAR; PG8_MMA(0, 0, At, B0); PG8_MMA(0, 1, At, B1); PG8_BAR; PG8_SCHED;
            PG8_LDA(At, 1, 1); PG8_STAGE(PG8_SB(1, 0), b3, voffB); PG8_STAGE(PG8_SB(1, 1), b3 + hstep, voffB); PG8_STAGE(PG8_SA(1, 0), a3, voffA);
            PG8_WAIT_V(8); PG8_WAIT_L(0); PG8_BAR; PG8_MMA(1, 0, At, B0); PG8_MMA(1, 1, At, B1); PG8_BAR; PG8_SCHED;
            } else {
            PG8_LDB(B0, 0, 0); PG8_SCHED; PG8_LDA(At, 0, 0); PG8_STAGE(PG8_SA(1, 1), a1 + hstep, voffA);
            PG8_WAIT_L(8); PG8_BAR; PG8_WAIT_L(0); PG8_MMA(0, 0, At, B0); PG8_BAR; PG8_SCHED;
            PG8_LDB(B1, 0, 1); PG8_STAGE(PG8_SB(0, 0), b2, voffB);
            PG8_BAR; PG8_WAIT_L(0); PG8_MMA(0, 1, At, B1); PG8_BAR;
            PG8_LDA(At, 0, 1); PG8_STAGE(PG8_SA(0, 0), a2, voffA);
            PG8_BAR; PG8_WAIT_L(0); PG8_MMA(1, 0, At, B0); PG8_BAR; PG8_SCHED;
            PG8_STAGE(PG8_SB(0, 1), b2 + hstep, voffB);
            PG8_WAIT_V(6); PG8_BAR; PG8_MMA(1, 1, At, B1); PG8_BAR;
            PG8_LDB(B0, 1, 0); PG8_SCHED; PG8_LDA(At, 1, 0); PG8_STAGE(PG8_SA(0, 1), a2 + hstep, voffA);
            PG8_WAIT_L(8); PG8_BAR; PG8_WAIT_L(0); PG8_MMA(0, 0, At, B0); PG8_BAR; PG8_SCHED;
            PG8_LDB(B1, 1, 1); PG8_STAGE(PG8_SB(1, 0), b3, voffB);
            PG8_BAR; PG8_WAIT_L(0); PG8_MMA(0, 1, At, B1); PG8_BAR;
            PG8_LDA(At, 1, 1); PG8_STAGE(PG8_SA(1, 0), a3, voffA);
            PG8_BAR; PG8_WAIT_L(0); PG8_MMA(1, 0, At, B0); PG8_BAR; PG8_SCHED;
            PG8_STAGE(PG8_SB(1, 1), b3 + hstep, voffB);
            PG8_WAIT_V(6); PG8_BAR; PG8_MMA(1, 1, At, B1); PG8_BAR;
            }
        }
        if constexpr (ALIGN_EPI) { if (wr == 0) PG8_BAR; }
        if constexpr (!Epi::AFTER_DRAIN) { E(acc, cur, wr, wc, fr, fq); S.done(cur); }
        if (!has_next) break;
#pragma unroll
        for (int a = 0; a < 2; ++a)
#pragma unroll
            for (int b = 0; b < 2; ++b)
#pragma unroll
                for (int m = 0; m < 4; ++m)
#pragma unroll
                    for (int n = 0; n < 2; ++n) acc[a][b][m][n] = (f32x4){0.f, 0.f, 0.f, 0.f};
        cur = nxt; cA = nA; cB = nB; ++ui;
        if constexpr (ALIGN_EPI) { if (wr == 1) PG8_BAR; }
    }
    PG8_WAIT_V(0);
    if constexpr (!ALIGN_EPI) { if (wr == 0) PG8_BAR; }
    PG8_BAR;
    if constexpr (Epi::AFTER_DRAIN) { E.fused(acc, cur, wr, wc, fr, fq, lds, wid, lane); S.done(cur); }
#undef PG8_SA
#undef PG8_SB
#undef PG8_STAGE
#undef PG8_LDA
#undef PG8_LDB
#undef PG8_MMA
#undef PG8_WAIT_V
#undef PG8_WAIT_L
#undef PG8_BAR
#undef PG8_SCHED
}
}

#ifndef PG8_SP2
#define PG8_SP2 true
#endif
#ifndef PG8_ALIGN
#define PG8_ALIGN true
#endif
#include <hip/hip_bf16.h>
#include <cmath>
namespace attn_body {
using bf16=__hip_bfloat16;
using bf16x8=__attribute__((ext_vector_type(8)))short;
using s16x4=__attribute__((ext_vector_type(4)))short;
using f32x16=__attribute__((ext_vector_type(16)))float;
using u32x4=__attribute__((ext_vector_type(4)))unsigned;
constexpr int BATCH=2,NHEAD=16,SEQ=8192,D=64,DM=NHEAD*D;
constexpr int NW=8,QBLK=32,QB=QBLK*NW,KVBLK=64,NQB=SEQ/QB;
constexpr int ATTN_PITCH=DM, ATTN_UNIT_ROWS=QB;
__device__ __forceinline__ int crow(int r,int hi){return (r&3)+8*(r>>2)+4*hi;}
#define SBAR() __builtin_amdgcn_sched_barrier(0)
__device__ __forceinline__ void cmask(f32x16&p0,f32x16&p1,int jb,int qrel,int hi){
  const float NEG=-INFINITY; int kb=64*jb+4*hi;
  #pragma unroll
  for(int r=0;r<16;++r){int kv=kb+(r&3)+8*(r>>2); if(kv>qrel)p0[r]=NEG; if(kv+32>qrel)p1[r]=NEG;}
}

constexpr int NSLOT=3, SLOTB=8192;
constexpr int LDS_K=0, LDS_V=NSLOT*SLOTB, LDS_WS=2*NSLOT*SLOTB, LDS_OST=LDS_WS+NW*64*4, LDS_BYTES=LDS_OST+NW*4096;
constexpr float C2=0.125f*1.4426950408889634f;
__device__ __forceinline__ void glds16(const void*gsrc,unsigned lds_dst){unsigned keep;
  asm volatile("s_mov_b32 %0, m0\n\ts_mov_b32 m0, %2\n\ts_nop 0\n\tglobal_load_lds_dwordx4 %1, off\n\ts_mov_b32 m0, %0":"=&s"(keep):"v"(gsrc),"s"(lds_dst):"memory");}
__device__ __forceinline__ float max3f(float a,float b,float c){float r;asm("v_max3_f32 %0, %1, %2, %3":"=v"(r):"v"(a),"v"(b),"v"(c));return r;}
__device__ __forceinline__ float max2f(float a,float b){float r;asm("v_max_f32_e32 %0, %1, %2":"=v"(r):"v"(a),"v"(b));return r;}
__device__ __forceinline__ float fadd_s(float a,float b){float r;asm("v_add_f32_e32 %0, %1, %2":"=v"(r):"v"(a),"v"(b));return r;}
__device__ __forceinline__ float fsub_s(float a,float b){float r;asm("v_sub_f32_e32 %0, %1, %2":"=v"(r):"v"(a),"v"(b));return r;}
typedef float f32x2_t __attribute__((ext_vector_type(2))); typedef float f32x4_t __attribute__((ext_vector_type(4))); typedef __bf16 bf16x2_t __attribute__((ext_vector_type(2)));
__device__ __forceinline__ unsigned cvtpk_s(float lo,float hi){f32x2_t v={lo,hi};bf16x2_t b=__builtin_convertvector(v,bf16x2_t);return __builtin_bit_cast(unsigned,b);}
#define WAIT_BAR(N) asm volatile("s_waitcnt vmcnt(" #N ") lgkmcnt(0)\n\ts_barrier":::"memory")

__device__ __forceinline__ void qkt(f32x16&p0,f32x16&p1,const char*Kslot,const bf16x8*qr,const f32x16&negm,int r32,int hi){
  const char*kb=Kslot+hi*1024+r32*16;
  #pragma unroll
  for(int d0=0;d0<4;++d0){
    const bf16x8 b0=*reinterpret_cast<const bf16x8*>(kb+d0*2048);
    const bf16x8 b1=*reinterpret_cast<const bf16x8*>(kb+d0*2048+512);
    if(d0==0){p0=__builtin_amdgcn_mfma_f32_32x32x16_bf16(b0,qr[0],negm,0,0,0);p1=__builtin_amdgcn_mfma_f32_32x32x16_bf16(b1,qr[0],negm,0,0,0);}
    else{p0=__builtin_amdgcn_mfma_f32_32x32x16_bf16(b0,qr[d0],p0,0,0,0);p1=__builtin_amdgcn_mfma_f32_32x32x16_bf16(b1,qr[d0],p1,0,0,0);}}
}
typedef __attribute__((address_space(3))) const char* lds_cptr;
typedef short v4i16_t __attribute__((ext_vector_type(4)));
__device__ __forceinline__ void kload8(bf16x8*kf,lds_cptr kp){
  kf[0]=*(const __attribute__((address_space(3))) bf16x8*)(kp);      kf[1]=*(const __attribute__((address_space(3))) bf16x8*)(kp+512);
  kf[2]=*(const __attribute__((address_space(3))) bf16x8*)(kp+2048); kf[3]=*(const __attribute__((address_space(3))) bf16x8*)(kp+2560);
  kf[4]=*(const __attribute__((address_space(3))) bf16x8*)(kp+4096); kf[5]=*(const __attribute__((address_space(3))) bf16x8*)(kp+4608);
  kf[6]=*(const __attribute__((address_space(3))) bf16x8*)(kp+6144); kf[7]=*(const __attribute__((address_space(3))) bf16x8*)(kp+6656);
}
__device__ __forceinline__ void kload2(bf16x8*kf,lds_cptr kp,int j){ kf[2*j]=*(const __attribute__((address_space(3))) bf16x8*)(kp+j*2048); kf[2*j+1]=*(const __attribute__((address_space(3))) bf16x8*)(kp+j*2048+512); }
__device__ __forceinline__ s16x4 vtr(lds_cptr p){ return __builtin_bit_cast(s16x4,__builtin_amdgcn_ds_read_tr16_b64_v4i16((__attribute__((address_space(3))) v4i16_t*)p)); }
__device__ __forceinline__ float rowmax(const f32x16&p0,const f32x16&p1){
  float a=max3f(p0[0],p0[1],p1[0]),b=max3f(p0[2],p0[3],p1[1]);a=max3f(a,p1[2],p1[3]);
  #pragma unroll
  for(int r=4;r<16;r+=4){a=max3f(a,p0[r],p0[r+1]);b=max3f(b,p0[r+2],p0[r+3]);a=max3f(a,p1[r],p1[r+1]);b=max3f(b,p1[r+2],p1[r+3]);}
  const float m=max2f(a,b);
  auto rr=__builtin_amdgcn_permlane32_swap(__float_as_uint(m),__float_as_uint(m),false,false);
  return max2f(__uint_as_float(rr[0]),__uint_as_float(rr[1]));
}
__device__ __forceinline__ void pv(f32x16*o,int vb,bf16x8 pa0,bf16x8 pa1,bf16x8 pa2,bf16x8 pa3){
  #pragma unroll
  for(int d0=0;d0<2;++d0){s16x4 lo[4],hi[4];
    #pragma unroll
    for(int ks=0;ks<4;++ks){
      asm volatile("ds_read_b64_tr_b16 %0,%1 offset:%c2":"=&v"(lo[ks]):"v"(vb),"i"(d0*4096+ks*1024):"memory");
      asm volatile("ds_read_b64_tr_b16 %0,%1 offset:%c2":"=&v"(hi[ks]):"v"(vb),"i"(d0*4096+ks*1024+512):"memory");}
    asm volatile("s_waitcnt lgkmcnt(0)":::"memory");SBAR();
    #define PK(k) (bf16x8){lo[k][0],lo[k][1],lo[k][2],lo[k][3],hi[k][0],hi[k][1],hi[k][2],hi[k][3]}
    o[d0]=__builtin_amdgcn_mfma_f32_32x32x16_bf16(pa0,PK(0),o[d0],0,0,0);
    o[d0]=__builtin_amdgcn_mfma_f32_32x32x16_bf16(pa1,PK(1),o[d0],0,0,0);
    o[d0]=__builtin_amdgcn_mfma_f32_32x32x16_bf16(pa2,PK(2),o[d0],0,0,0);
    o[d0]=__builtin_amdgcn_mfma_f32_32x32x16_bf16(pa3,PK(3),o[d0],0,0,0);
    #undef PK
  }
}

#ifndef ATTN_STORE16
#define ATTN_STORE16(p,v) (*(u32x4*)(p)=(v))
#endif
typedef __attribute__((address_space(3))) const float* lds_cfptr;
#define FOXBIAS(C0,C1,t) do{ const lds_cfptr cb_=cumL+64*(t)+4*hi; \
    _Pragma("unroll") for(int g_=0;g_<4;++g_){ const f32x4_t b0_=*(const __attribute__((address_space(3))) f32x4_t*)(cb_+8*g_); const f32x4_t b1_=*(const __attribute__((address_space(3))) f32x4_t*)(cb_+32+8*g_); \
      _Pragma("unroll") for(int e_=0;e_<4;++e_){ C0[4*g_+e_]-=(b0_[e_]+mhat); C1[4*g_+e_]-=(b1_[e_]+mhat); } } }while(0)
template<int THRL> __device__ __forceinline__ void attn_unit(int b,int h,int qb,const bf16*Q,const bf16*__restrict__ K,const bf16*__restrict__ V,const bf16*__restrict__ Gt,bf16*O,char*shm,lds_cfptr cumL){
  int tid_=threadIdx.x; asm volatile("":"+v"(tid_)); const int tid=tid_,lane=tid&63,r32=lane&31,hi=lane>>5; const int wid=__builtin_amdgcn_readfirstlane(tid>>6);
  const long rowbase=(long)b*SEQ; const int q0=qb*QB;
  const bf16*Qw=Q+(rowbase+q0+wid*QBLK)*DM+h*D;
  const bf16*Kh=K+rowbase*DM+h*D,*Vh=V+rowbase*DM+h*D;
  const unsigned lds0=(unsigned)(uintptr_t)shm;
  float*wsf=(float*)(shm+LDS_WS)+wid*64;
  const bf16*ksrc=Kh+(long)lane*DM+wid*8;
  const bf16*vsrc=Vh+(long)(16*(wid&3)+(lane>>2))*DM+(wid>>2)*32+(lane&3)*8;
  const unsigned kdst=lds0+LDS_K+wid*1024, vdst=lds0+LDS_V+wid*1024;
  #define DMA_K(t,slot) glds16(ksrc+(long)(t)*KVBLK*DM,(unsigned)__builtin_amdgcn_readfirstlane(kdst+(slot)))
  #define DMA_V(t,slot) glds16(vsrc+(long)(t)*KVBLK*DM,(unsigned)__builtin_amdgcn_readfirstlane(vdst+(slot)))
  const int vb0=(int)(lds0+LDS_V)+((lane>>4)&1)*32+(lane&3)*8+(4*hi+((lane&15)>>2))*64;
  const char*Kbase=shm+LDS_K; bf16x8 kf[8];
  const lds_cptr shm3=(lds_cptr)shm; const lds_cptr kp0=shm3+LDS_K+hi*1024+r32*16; const lds_cptr vp0=shm3+LDS_V+((lane>>4)&1)*32+(lane&3)*8+(4*hi+((lane&15)>>2))*64;
  const int NT=(q0+QB)/KVBLK;
  DMA_K(0,0);DMA_V(0,0);DMA_K(1,SLOTB);
  bf16x8 qr[4];
  #pragma unroll
  for(int d0=0;d0<4;++d0)qr[d0]=*reinterpret_cast<const bf16x8*>(&Qw[(long)r32*DM+d0*16+hi*8]);
  const float cbq=cumL[qb*QB+wid*QBLK+r32];
  float mhat=-cbq,l_reg=0.f;f32x16 o[2];o[0]=f32x16{};o[1]=f32x16{};const f32x16 negm=f32x16{};
  const int qrel=wid*QBLK+r32;
  #define CMASK(P0,P1,t) do{int jb_=(t)-(NT-4); if(jb_>=0)cmask(P0,P1,jb_,qrel,hi);}while(0)
  bool resc=false;
  #define START(P0,P1) do{ const float rm=rowmax(P0,P1); resc=false; \
    { const float dl=rm; mhat=fadd_s(mhat,dl); \
      _Pragma("unroll") for(int r=0;r<16;++r){P0[r]=fsub_s(P0[r],dl);P1[r]=fsub_s(P1[r],dl);} \
      } \
    _Pragma("unroll") for(int r=0;r<16;++r)P0[r]=__builtin_amdgcn_exp2f(P0[r]); }while(0)
  #define RESC() do{ if(resc){ asm volatile("s_waitcnt lgkmcnt(0)":::"memory"); \
      _Pragma("unroll") for(int d_=0;d_<2;++d_) _Pragma("unroll") for(int r=0;r<16;++r)o[d_][r]*=wsf[crow(r,hi)]; } }while(0)
  f32x16 pA0,pA1,pB0,pB1;
  int sl_prev=0,sl_cur=0,sl_next=SLOTB;
  #define ROT() do{sl_prev=sl_cur;sl_cur=sl_next;sl_next=(sl_next==(NSLOT-1)*SLOTB)?0:sl_next+SLOTB;}while(0)
  DMA_K(2,2*SLOTB);
  WAIT_BAR(3);
  qkt(pA0,pA1,Kbase,qr,negm,r32,hi);asm volatile("s_nop 15\n\ts_nop 7":"+v"(pA0),"+v"(pA1));FOXBIAS(pA0,pA1,0);CMASK(pA0,pA1,0);
  START(pA0,pA1);
  _Pragma("unroll") for(int r=0;r<16;++r)pA1[r]=__builtin_amdgcn_exp2f(pA1[r]);
  WAIT_BAR(0);
  DMA_K(3,0);DMA_V(1,SLOTB);
  ROT();
  kload8(kf,kp0+sl_cur);
  WAIT_BAR(2);
  s16x4 vlo[8],vhi[8]; u32x4 pw0,pw1,pw2,pw3;
  #define PKW(P,B) cvtpk_s(P[B],P[B+1])
  #define PAF(k) __builtin_bit_cast(bf16x8,pw##k)
  #define VFR(i) (bf16x8){vlo[i][0],vlo[i][1],vlo[i][2],vlo[i][3],vhi[i][0],vhi[i][1],vhi[i][2],vhi[i][3]}
  #define PIN(x) asm volatile("":"+v"(x))
  #define MX3(a,b,c) __builtin_fmaxf(__builtin_fmaxf((a),(b)),(c))
  #define GAPA(MF,A0,A1,A2,A3,W0,W1,PW) do{ MF; sacc+=A0; sacc+=A1; sacc+=A2; sacc+=A3; PIN(sacc); W0; W1; PIN(PW); SBAR(); }while(0)
  #define EX(v) __builtin_amdgcn_exp2f(v)
  #define GAPB(MF,X,B) do{ MF; X[B]=EX(X[B]); X[B+1]=EX(X[B+1]); X[B+2]=EX(X[B+2]); X[B+3]=EX(X[B+3]); PIN(X); SBAR(); }while(0)
  #define VRD(i) do{ vlo[i]=vtr(vp_+(((i)>>2)*4096+((i)&3)*1024)); vhi[i]=vtr(vp_+(((i)>>2)*4096+((i)&3)*1024+512)); }while(0)
  #define KRD(G,j) do{ if(G){ kload2(kf,kp0+sl_next,j); SBAR(); } }while(0)
  #define STEP(C0,C1,P0,P1,t,GK,GV,GL) do{ SBAR(); \
    const lds_cptr vp_=vp0+sl_prev; \
    VRD(0); SBAR(); float sacc=(P0[0]+P0[1]); \
    GAPA(C0=__builtin_amdgcn_mfma_f32_32x32x16_bf16(kf[0],qr[0],negm,0,0,0), P0[2],P0[3],P0[4],P0[5],     pw0[0]=PKW(P0,0), pw0[1]=PKW(P0,2), pw0); \
    VRD(4); SBAR(); GAPA(C1=__builtin_amdgcn_mfma_f32_32x32x16_bf16(kf[1],qr[0],negm,0,0,0), P0[6],P0[7],P0[8],P0[9],     pw0[2]=PKW(P0,4), pw0[3]=PKW(P0,6), pw0); \
    VRD(1); SBAR(); GAPA(C0=__builtin_amdgcn_mfma_f32_32x32x16_bf16(kf[2],qr[1],C0,0,0,0),   P0[10],P0[11],P0[12],P0[13], pw1[0]=PKW(P0,8), pw1[1]=PKW(P0,10), pw1); \
    VRD(5); SBAR(); GAPA(C1=__builtin_amdgcn_mfma_f32_32x32x16_bf16(kf[3],qr[1],C1,0,0,0),   P0[14],P0[15],P1[0],P1[1],   pw1[2]=PKW(P0,12),pw1[3]=PKW(P0,14), pw1); \
    VRD(2); SBAR(); GAPA(C0=__builtin_amdgcn_mfma_f32_32x32x16_bf16(kf[4],qr[2],C0,0,0,0),   P1[2],P1[3],P1[4],P1[5],     pw2[0]=PKW(P1,0), pw2[1]=PKW(P1,2), pw2); \
    VRD(6); SBAR(); GAPA(C1=__builtin_amdgcn_mfma_f32_32x32x16_bf16(kf[5],qr[2],C1,0,0,0),   P1[6],P1[7],P1[8],P1[9],     pw2[2]=PKW(P1,4), pw2[3]=PKW(P1,6), pw2); \
    VRD(3); SBAR(); GAPA(C0=__builtin_amdgcn_mfma_f32_32x32x16_bf16(kf[6],qr[3],C0,0,0,0),   P1[10],P1[11],P1[12],P1[13], pw3[0]=PKW(P1,8), pw3[1]=PKW(P1,10), pw3); \
    VRD(7); SBAR(); GAPA(C1=__builtin_amdgcn_mfma_f32_32x32x16_bf16(kf[7],qr[3],C1,0,0,0),   P1[14],P1[15],0.f,0.f,       pw3[2]=PKW(P1,12),pw3[3]=PKW(P1,14), pw3); \
    l_reg+=sacc; \
    if(GK){DMA_K((t)+3,sl_cur);} if(GV){DMA_V((t)+1,sl_next);} \
    FOXBIAS(C0,C1,t); CMASK(C0,C1,t); \
    { float a=MX3(C0[0],C0[1],C1[0]),b=MX3(C0[2],C0[3],C1[1]); a=MX3(a,C1[2],C1[3]); \
      _Pragma("unroll") for(int r=4;r<16;r+=4){a=MX3(a,C0[r],C0[r+1]);b=MX3(b,C0[r+2],C0[r+3]);a=MX3(a,C1[r],C1[r+1]);b=MX3(b,C1[r+2],C1[r+3]);} \
      float rm=__builtin_fmaxf(a,b); { auto rr=__builtin_amdgcn_permlane32_swap(__float_as_uint(rm),__float_as_uint(rm),false,false); rm=__builtin_fmaxf(__uint_as_float(rr[0]),__uint_as_float(rr[1])); } \
      resc=false; \
      if(__builtin_expect(__any(rm>(float)THRL),0)){ const float dl=__builtin_fmaxf(rm,0.f); mhat+=dl; \
        _Pragma("unroll") for(int r=0;r<16;++r){C0[r]-=dl;C1[r]-=dl;} \
        const float f=__builtin_amdgcn_exp2f(-dl); l_reg*=f; if(hi==0)wsf[r32]=f; resc=true; } } \
    SBAR(); \
    GAPB(o[0]=__builtin_amdgcn_mfma_f32_32x32x16_bf16(PAF(0),VFR(0),o[0],0,0,0), C0,0); \
    GAPB(o[1]=__builtin_amdgcn_mfma_f32_32x32x16_bf16(PAF(0),VFR(4),o[1],0,0,0), C0,4); \
    KRD(GL,0); GAPB(o[0]=__builtin_amdgcn_mfma_f32_32x32x16_bf16(PAF(1),VFR(1),o[0],0,0,0), C0,8); \
    KRD(GL,1); GAPB(o[1]=__builtin_amdgcn_mfma_f32_32x32x16_bf16(PAF(1),VFR(5),o[1],0,0,0), C0,12); \
    KRD(GL,2); GAPB(o[0]=__builtin_amdgcn_mfma_f32_32x32x16_bf16(PAF(2),VFR(2),o[0],0,0,0), C1,0); \
    KRD(GL,3); GAPB(o[1]=__builtin_amdgcn_mfma_f32_32x32x16_bf16(PAF(2),VFR(6),o[1],0,0,0), C1,4); \
    GAPB(o[0]=__builtin_amdgcn_mfma_f32_32x32x16_bf16(PAF(3),VFR(3),o[0],0,0,0), C1,8); \
    GAPB(o[1]=__builtin_amdgcn_mfma_f32_32x32x16_bf16(PAF(3),VFR(7),o[1],0,0,0), C1,12); \
    }while(0)
  int t=1;
  #undef CMASK
  #define CMASK(P0,P1,t) do{}while(0)
  for(;t+5<NT;t+=2){
    STEP(pB0,pB1,pA0,pA1,t,true,true,true);     WAIT_BAR(2); RESC(); ROT();
    STEP(pA0,pA1,pB0,pB1,t+1,true,true,true);   WAIT_BAR(2); RESC(); ROT();
  }
  #undef CMASK
  #define CMASK(P0,P1,t) do{int jb_=(t)-(NT-4); if(jb_>=0)cmask(P0,P1,jb_,qrel,hi);}while(0)
  #define ENDW(tt) do{ if((tt)+3<NT){WAIT_BAR(2);} else if((tt)+2<NT){WAIT_BAR(1);} else {WAIT_BAR(0);} }while(0)
  for(;t+1<NT;t+=2){
    STEP(pB0,pB1,pA0,pA1,t,(t+3<NT),(t+1<NT),(t+1<NT));       ENDW(t);   RESC(); ROT();
    STEP(pA0,pA1,pB0,pB1,t+1,(t+4<NT),(t+2<NT),(t+2<NT));     ENDW(t+1); RESC(); ROT();
  }
  STEP(pB0,pB1,pA0,pA1,NT-1,false,false,false); RESC();
  { float sacc=pB0[0]+pB0[1]; _Pragma("unroll") for(int r=2;r<16;++r)sacc+=pB0[r]; _Pragma("unroll") for(int r=0;r<16;++r)sacc+=pB1[r]; l_reg+=sacc;
    pw0=(u32x4){PKW(pB0,0),PKW(pB0,2),PKW(pB0,4),PKW(pB0,6)};pw1=(u32x4){PKW(pB0,8),PKW(pB0,10),PKW(pB0,12),PKW(pB0,14)};pw2=(u32x4){PKW(pB1,0),PKW(pB1,2),PKW(pB1,4),PKW(pB1,6)};pw3=(u32x4){PKW(pB1,8),PKW(pB1,10),PKW(pB1,12),PKW(pB1,14)};
    SBAR(); pv(o,vb0+sl_cur,PAF(0),PAF(1),PAF(2),PAF(3)); }
  #undef PKW
  #undef PAF
  #undef VFR
  #undef PIN
  #undef MX3
  #undef GAPA
  #undef GAPB
  #undef EX
  #undef VRD
  #undef KRD
  #undef STEP
  #undef ENDW
  {auto rr=__builtin_amdgcn_permlane32_swap(__float_as_uint(l_reg),__float_as_uint(l_reg),false,false);l_reg=__uint_as_float(rr[0])+__uint_as_float(rr[1]);}
  if(hi==0)wsf[32+r32]=l_reg;asm volatile("s_waitcnt lgkmcnt(0)":::"memory");
  float rli[16];
  #pragma unroll
  for(int r=0;r<16;++r)rli[r]=__builtin_amdgcn_rcpf(wsf[32+crow(r,hi)]);
  bf16*Ow=O+(rowbase+q0+wid*QBLK)*DM+h*D; const bf16*Gw=Gt+(rowbase+q0+wid*QBLK)*DM+h*D;
  { bf16*stg=(bf16*)(shm+LDS_OST)+wid*2048;
    #pragma unroll
    for(int r=0;r<16;++r){const int orow=crow(r,hi);
      #pragma unroll
      for(int d0=0;d0<2;++d0)stg[orow*64+d0*32+r32]=__float2bfloat16(o[d0][r]*rli[r]);}
    asm volatile("s_waitcnt lgkmcnt(0)":::"memory");
    #pragma unroll
    for(int i=0;i<4;++i){const int row=i*8+(lane>>3),ch=lane&7; u32x4 v=*(const u32x4*)(stg+row*64+ch*8); const u32x4 gq=*(const u32x4*)(Gw+(long)row*DM+ch*8);
      _Pragma("unroll") for(int e=0;e<4;++e){ const unsigned a_=v[e],g_=gq[e]; v[e]=cvtpk_s(__uint_as_float(a_<<16)*__uint_as_float(g_<<16),__uint_as_float(a_&0xffff0000u)*__uint_as_float(g_&0xffff0000u)); }
      ATTN_STORE16(Ow+(long)row*DM+ch*8,v);} }
  asm volatile("s_waitcnt lgkmcnt(0)\n\ts_barrier":::"memory");
  #undef DMA_K
  #undef DMA_V
  #undef CMASK
  #undef START
  #undef RESC
  #undef ROT
}
constexpr int ATTN_LDS_BYTES=LDS_BYTES;
struct AttnTensors { const bf16* Q; const bf16* K; const bf16* V; const bf16* G; bf16* O; };
struct AttnUnit { int bh; int qb; };
struct StaticOrder {
  int vcu;
  __device__ __forceinline__ explicit StaticOrder(int grid,int block):vcu((block%8)*(grid/8)+block/8){}
  __device__ __forceinline__ bool next(int i,AttnUnit&u)const{ if(i>=4)return false; const int s=vcu&7; u.bh=vcu>>3; u.qb=(i==0)?s:(i==1)?15-s:(i==2)?16+s:31-s; return true; }
  __device__ __forceinline__ void a_ready(const AttnUnit&)const{}
  __device__ __forceinline__ void done(const AttnUnit&)const{}
};
template<class Sched,int THRL=8> __device__ __forceinline__ void attn_phase(char*lds,const AttnTensors&T,const Sched&S,lds_cfptr cumL){
  AttnUnit u;
  for(int i=0;S.next(i,u);++i){ S.a_ready(u); attn_unit<THRL>(u.bh/NHEAD,u.bh%NHEAD,u.qb,T.Q,T.K,T.V,T.G,T.O,lds,cumL); S.done(u); }
}
#undef SBAR
#undef WAIT_BAR
}
#define GAS __attribute__((address_space(1)))
#define LAS __attribute__((address_space(3)))
typedef unsigned short bf16;
typedef unsigned v4u __attribute__((ext_vector_type(4)));
typedef float f32x4 __attribute__((ext_vector_type(4)));
typedef short bf16x8 __attribute__((ext_vector_type(8)));
typedef GAS unsigned gu32;
typedef GAS unsigned long long gu64;
#define RLX_AGENT __ATOMIC_RELAXED, __HIP_MEMORY_SCOPE_AGENT
#define LDS_WAIT() asm volatile("s_waitcnt lgkmcnt(0)" ::: "memory")
#define VM_WAIT() asm volatile("s_waitcnt vmcnt(0)" ::: "memory")
__device__ __forceinline__ unsigned long long rt() { return __builtin_amdgcn_s_memrealtime(); }
__device__ __forceinline__ unsigned f2bf(float f) { unsigned u = __builtin_bit_cast(unsigned, f); return (u + 0x7fffu + ((u >> 16) & 1u)) >> 16; }
__device__ __forceinline__ unsigned pk2(float lo, float hi) { return f2bf(lo) | (f2bf(hi) << 16); }

#define XB_TMO      128
#define XB_XCNT(j)  (256  + 64 * (j))
#define XB_XSUB(j)  (1280 + 64 * (j))
#define XB_XGEN(j)  (2304 + 64 * (j))
#define XB_TOP      3328
#define XB_TOPGEN   3392
#define XCD_BAR_WORDS 3456
#define XB_SPIN_CAP (1u << 18)

__device__ __forceinline__ unsigned xb_ld(unsigned* p)              { return __hip_atomic_load(p, __ATOMIC_RELAXED, __HIP_MEMORY_SCOPE_AGENT); }
__device__ __forceinline__ unsigned xb_add(unsigned* p, unsigned v) { return __hip_atomic_fetch_add(p, v, __ATOMIC_RELAXED, __HIP_MEMORY_SCOPE_AGENT); }
__device__ __forceinline__ unsigned xb_xcc_id() { return (unsigned)__builtin_amdgcn_s_getreg((3 << 11) | 20) & 0xFu; }
#define XB_SPIN(cond, bar) do { unsigned _sp = 0; while (cond) { __builtin_amdgcn_s_sleep(1); \
    if ((++_sp & 255u) == 0u) { if (xb_ld(&(bar)[XB_TMO])) break; if (_sp > XB_SPIN_CAP) { atomicAdd(&(bar)[XB_TMO], 1u); break; } } } } while (0)

struct XcdBarrier {
    unsigned* bar; unsigned x;
    volatile LAS unsigned* st;
};

__device__ __forceinline__ XcdBarrier xcd_barrier_post(unsigned* bar, volatile LAS unsigned* st) {
    XcdBarrier b; b.bar = bar; b.x = xb_xcc_id(); b.st = st;
    if (threadIdx.x == 0) (void)xb_add(&bar[XB_XCNT(b.x)], 1u);
    return b;
}
__device__ __forceinline__ void xcd_barrier_complete(unsigned* bar, unsigned x, unsigned& nloc, unsigned& nx) {
    const unsigned G = gridDim.x * gridDim.y * gridDim.z;
    unsigned sum, cnt, mine, sp = 0u;
    for (;;) {
        sum = 0u; cnt = 0u; mine = 0u;
#pragma unroll
        for (unsigned j = 0; j < 16; ++j) { const unsigned c = xb_ld(&bar[XB_XCNT(j)]); sum += c; cnt += (c > 0u) ? 1u : 0u; mine = (j == x) ? c : mine; }
        if (sum == G) break;
        __builtin_amdgcn_s_sleep(1);
        if ((++sp & 255u) == 0u) { if (xb_ld(&bar[XB_TMO])) break; if (sp > XB_SPIN_CAP) { atomicAdd(&bar[XB_TMO], 1u); break; } }
    }
    nloc = mine > 0u ? mine : 1u; nx = cnt > 0u ? cnt : 1u;
}

__device__ __forceinline__ void xcd_barrier(const XcdBarrier& b) {
    asm volatile("s_waitcnt vmcnt(0)" ::: "memory");
    __syncthreads();
    if (threadIdx.x == 0) {
        unsigned* bar = b.bar; unsigned bx_ = b.x; asm volatile("" : "+s"(bx_), "+s"(bar));
        __builtin_amdgcn_s_waitcnt(0);
        unsigned nloc = b.st[0], nx = b.st[1];
        if (nloc == 0u) { xcd_barrier_complete(bar, bx_, nloc, nx); b.st[0] = nloc; b.st[1] = nx; }
        const unsigned old = xb_add(&bar[XB_XSUB(bx_)], 1u);
        const unsigned gen = old / nloc;
        if (old + 1u == (gen + 1u) * nloc) {
            __builtin_amdgcn_fence(__ATOMIC_RELEASE, "agent");
            asm volatile("s_waitcnt vmcnt(0)" ::: "memory");
            const unsigned og = xb_add(&bar[XB_TOP], 1u);
            const unsigned tg = og / nx;
            if (og + 1u == (tg + 1u) * nx) xb_add(&bar[XB_TOPGEN], 1u);
            else XB_SPIN(xb_ld(&bar[XB_TOPGEN]) == tg, bar);
            __builtin_amdgcn_fence(__ATOMIC_ACQUIRE, "agent");
            xb_add(&bar[XB_XGEN(bx_)], 1u);
            asm volatile("s_waitcnt vmcnt(0)" ::: "memory");
        } else {
            XB_SPIN(xb_ld(&bar[XB_XGEN(bx_)]) == gen, bar);
            __builtin_amdgcn_fence(__ATOMIC_ACQUIRE, "agent");
            asm volatile("s_waitcnt vmcnt(0)" ::: "memory");
        }
    }
    __syncthreads();
}
typedef float f32x2 __attribute__((ext_vector_type(2)));
constexpr int NWAVES = 8;
constexpr int BATCH = 2, SEQ = 8192, D = 1024, M = BATCH * SEQ, FF = 2816, NUP = 2 * FF, NADA = 9 * D, FOXLD = 4 * D + 16, DEPTH = 2;
constexpr float EPS = 1e-6f;
constexpr size_t MiB = 1u << 20;
constexpr size_t WS_CTL = 0, CTL_ZERO_BYTES = 1 * MiB;
constexpr size_t WS_MOD = 1 * MiB;
constexpr size_t WS_LB = 1 * MiB + 256 * 1024;
constexpr size_t WS_WUP = 2 * MiB, WUP_BYTES = (size_t)NUP * D * 2;
constexpr size_t WS_WDN = 46 * MiB, WDN_BYTES = (size_t)D * FF * 2;
constexpr size_t WS_WFIN = 68 * MiB, WS_WFOUT = 76 * MiB, WS_WHIN = 78 * MiB, WS_WHOUT = 86 * MiB;
constexpr size_t WS_H = 88 * MiB;
constexpr size_t WS_BIG = 120 * MiB;
constexpr size_t WS_ACT = WS_BIG;
constexpr size_t WS_FQ = WS_BIG, WS_FK = WS_BIG + 32 * MiB, WS_FV = WS_BIG + 64 * MiB, WS_FG = WS_BIG + 96 * MiB, WS_FLF = WS_BIG + 128 * MiB;
constexpr size_t WS_HQ = WS_BIG, WS_HO = WS_BIG + 32 * MiB, WS_HV = WS_BIG + 64 * MiB, WS_HG = WS_BIG + 96 * MiB, WS_HLF = WS_BIG + 128 * MiB, WS_HS = WS_BIG + 192 * MiB, WS_HD = WS_BIG + 208 * MiB;
constexpr size_t WS_END = WS_BIG + 210 * MiB;
constexpr int CW_TMO = 0, CW_CODE = 1, CW_BAR = 4096;

constexpr int RING_OFF = 0, RING_BYTES = 131072;
constexpr int LDSCTL_OFF = RING_BYTES, MISC_OFF = LDSCTL_OFF + 320;
constexpr int LDS_BYTES = 147456;
constexpr int ATT_CUM_OFF = 86016;
static_assert(attn_body::ATTN_LDS_BYTES <= ATT_CUM_OFF && ATT_CUM_OFF + SEQ * 4 <= RING_BYTES, "attention LDS map");

struct Frame {
    LAS unsigned char* lds;
    volatile LAS unsigned* MISC;
    gu32* ctl;
    int tid, lane, wave;
    int vcu, G;
};

__device__ __forceinline__ float wave_sum(float v) {
#pragma unroll
    for (int o = 1; o < 64; o <<= 1) v += __shfl_xor(v, o);
    return v;
}
__device__ __forceinline__ float bf2f(unsigned short b) { return __uint_as_float((unsigned)b << 16); }

__device__ __forceinline__ void p0_transpose_item(const float* W, int K, int ld, bf16* WT, int row_off, LAS float* scr, int k0, int n0, int lane) {
#pragma unroll 8
    for (int i = 0; i < 32; ++i) { const int kk = 2 * i + (lane >> 5); scr[kk * 33 + (lane & 31)] = W[(size_t)(k0 + kk) * ld + n0 + (lane & 31)]; }
    LDS_WAIT(); asm volatile("" ::: "memory");
    const int c = lane & 7;
#pragma unroll
    for (int j = 0; j < 4; ++j) { const int n = (lane >> 3) + 8 * j; const LAS float* s = scr + (8 * c) * 33 + n;
        v4u o; o.x = pk2(s[0 * 33], s[1 * 33]); o.y = pk2(s[2 * 33], s[3 * 33]); o.z = pk2(s[4 * 33], s[5 * 33]); o.w = pk2(s[6 * 33], s[7 * 33]);
        *(GAS v4u*)(WT + (size_t)(row_off + n0 + n) * K + k0 + 8 * c) = o; }
    LDS_WAIT(); asm volatile("" ::: "memory");
}

struct Ptrs {
    const float *x, *c, *ada_w, *ada_b, *norm_g, *w_up, *w_dn, *fox_w_in, *fox_b_f, *fox_w_out, *hgrn_w_in, *hgrn_norm_g, *hgrn_w_out, *lb_logits, *final_g;
    float* out; unsigned char* ws;
};

__device__ __forceinline__ void p0_prologue(Frame& F0, const Ptrs& P) {
    Frame F = F0; asm volatile("" : "+v"(F.tid)); F.lane = F.tid & 63;
    float* mod = (float*)(P.ws + WS_MOD);
    for (int it = blockIdx.x; it < DEPTH * (NADA / 256); it += F.G) {
        const int i = it / (NADA / 256), s = it % (NADA / 256);
        LAS float* condl = (LAS float*)(F.lds);
        LAS float* red = (LAS float*)(F.lds + 8192);
        for (int idx = F.tid; idx < BATCH * D; idx += NWAVES * 64) { const float cv = P.c[idx]; condl[idx] = cv / (1.0f + __expf(-cv)); }
        __syncthreads();
        float a0[4] = {0.f, 0.f, 0.f, 0.f}, a1[4] = {0.f, 0.f, 0.f, 0.f};
        const float* Wp = P.ada_w + (size_t)i * D * NADA + (size_t)(F.wave * 128) * NADA + s * 256 + F.lane * 4;
#pragma unroll 8
        for (int k = 0; k < 128; ++k) { const f32x4 w = *(const GAS f32x4*)(Wp + (size_t)k * NADA); const float c0 = condl[F.wave * 128 + k], c1 = condl[D + F.wave * 128 + k];
#pragma unroll
            for (int e = 0; e < 4; ++e) { a0[e] += c0 * w[e]; a1[e] += c1 * w[e]; } }
#pragma unroll
        for (int e = 0; e < 4; ++e) { red[(F.wave * 2 + 0) * 256 + F.lane * 4 + e] = a0[e]; red[(F.wave * 2 + 1) * 256 + F.lane * 4 + e] = a1[e]; }
        __syncthreads();
        { const int b = F.tid >> 8, col = F.tid & 255; float sum = P.ada_b[(size_t)i * NADA + s * 256 + col];
#pragma unroll
          for (int w = 0; w < 8; ++w) sum += red[(w * 2 + b) * 256 + col];
          mod[(size_t)(i * BATCH + b) * NADA + s * 256 + col] = sum; }
        __syncthreads();
    }
    if (blockIdx.x == F.G - 1) { float* lb = (float*)(P.ws + WS_LB);
        for (int cidx = F.tid; cidx < D; cidx += NWAVES * 64) { const float l0 = P.lb_logits[cidx], l1 = P.lb_logits[D + cidx]; lb[cidx] = 1.0f / (1.0f + __expf(l0 - l1)); } }
    LAS float* scr = (LAS float*)(F.lds + RING_OFF + F.wave * 16384);
    const int gw = F.vcu * NWAVES + F.wave, NGW = F.G * NWAVES;
    constexpr int I_UP = (D / 64) * (NUP / 32), I_DN = (FF / 64) * (D / 32), I_IN = (D / 64) * (4 * D / 32), I_OUT = (D / 64) * (D / 32);
    constexpr int NITEMS = 4 * I_UP + 4 * I_DN + 2 * I_IN + 2 * I_OUT;
    for (int it = gw; it < NITEMS; it += NGW) {
        int r = it;
        if (r < 4 * I_UP) { const int w = r / I_UP; r %= I_UP; const int nblk = NUP / 32, kb = r / nblk, nb = r % nblk, n0 = 32 * nb;
            const int np = (n0 < FF) ? n0 : n0 - FF; const int drow = (np / 128) * 256 + (n0 < FF ? 0 : 128) + (np % 128);
            p0_transpose_item(P.w_up + (size_t)w * D * NUP, D, NUP, (bf16*)(P.ws + WS_WUP + w * WUP_BYTES), drow - n0, scr, 64 * kb, n0, F.lane); continue; }
        r -= 4 * I_UP;
        if (r < 4 * I_DN) { const int w = r / I_DN; r %= I_DN; const int nblk = D / 32, kb = r / nblk, nb = r % nblk;
            p0_transpose_item(P.w_dn + (size_t)w * FF * D, FF, D, (bf16*)(P.ws + WS_WDN + w * WDN_BYTES), 0, scr, 64 * kb, 32 * nb, F.lane); continue; }
        r -= 4 * I_DN;
        if (r < I_IN) { const int nblk = 4 * D / 32, kb = r / nblk, nb = r % nblk; p0_transpose_item(P.fox_w_in, D, FOXLD, (bf16*)(P.ws + WS_WFIN), 0, scr, 64 * kb, 32 * nb, F.lane); continue; }
        r -= I_IN;
        if (r < I_IN) { const int nblk = 4 * D / 32, kb = r / nblk, nb = r % nblk; p0_transpose_item(P.hgrn_w_in, D, 4 * D, (bf16*)(P.ws + WS_WHIN), 0, scr, 64 * kb, 32 * nb, F.lane); continue; }
        r -= I_IN;
        if (r < I_OUT) { const int nblk = D / 32, kb = r / nblk, nb = r % nblk; p0_transpose_item(P.fox_w_out, D, D, (bf16*)(P.ws + WS_WFOUT), 0, scr, 64 * kb, 32 * nb, F.lane); continue; }
        r -= I_OUT;
        { const int nblk = D / 32, kb = r / nblk, nb = r % nblk; p0_transpose_item(P.hgrn_w_out, D, D, (bf16*)(P.ws + WS_WHOUT), 0, scr, 64 * kb, 32 * nb, F.lane); }
    }
}

template <bool FOX> __device__ __forceinline__ void norm_pass(Frame& F0, const float* xin, const float* g, const float* modp, bf16* H, const float* w_in, const float* b_f, float* FLF) {
    Frame F = F0; asm volatile("" : "+v"(F.tid)); F.lane = F.tid & 63;
    LAS float* WfT = (LAS float*)(F.lds);
    if (FOX) { for (int idx = F.tid; idx < 16 * D; idx += NWAVES * 64) { const int j = idx >> 10, k = idx & 1023; WfT[idx] = w_in[(size_t)k * FOXLD + 4 * D + j]; } __syncthreads(); }
    const int gw = F.vcu * NWAVES + F.wave, NGW = F.G * NWAVES;
    for (int m = gw; m < M; m += NGW) {
        const int b = m >= SEQ ? 1 : 0;
        const GAS f32x4* xr = (const GAS f32x4*)(xin + (size_t)m * D) + F.lane;
        const GAS f32x4* gr = (const GAS f32x4*)g + F.lane;
        const GAS f32x4* shr = (const GAS f32x4*)(modp + (size_t)b * NADA) + F.lane;
        const GAS f32x4* scr = (const GAS f32x4*)(modp + (size_t)b * NADA + D) + F.lane;
        f32x4 v[4]; float s = 0.f;
#pragma unroll
        for (int j = 0; j < 4; ++j) { v[j] = xr[64 * j]; s += (v[j].x * v[j].x + v[j].y * v[j].y) + (v[j].z * v[j].z + v[j].w * v[j].w); }
        const float rstd = 1.0f / sqrtf(wave_sum(s) * (1.f / D) + EPS);
        GAS unsigned long long* o8 = (GAS unsigned long long*)(H + (size_t)m * D) + F.lane;
#pragma unroll
        for (int j = 0; j < 4; ++j) { const f32x4 gg = gr[64 * j], sh = shr[64 * j], sc = scr[64 * j];
            v[j] = v[j] * rstd * gg * (sc + 1.0f) + sh;
            o8[64 * j] = (unsigned long long)pk2(v[j].x, v[j].y) | ((unsigned long long)pk2(v[j].z, v[j].w) << 32); }
        if (FOX) {
            float acc[16];
#pragma unroll
            for (int h = 0; h < 16; ++h) acc[h] = 0.f;
#pragma unroll
            for (int j = 0; j < 4; ++j) {
#pragma unroll
                for (int h = 0; h < 16; ++h) { const f32x4 w = *(const LAS f32x4*)(WfT + h * D + 256 * j + 4 * F.lane); acc[h] += (v[j].x * w.x + v[j].y * w.y) + (v[j].z * w.z + v[j].w * w.w); }
                asm volatile("" ::: "memory"); }
            const int L = F.lane; float r8[8], r4[4], r2[2], r1;
#pragma unroll
            for (int i = 0; i < 8; ++i) { const bool hb = (L & 32) != 0; const float keep = hb ? acc[i + 8] : acc[i], send = hb ? acc[i] : acc[i + 8]; r8[i] = keep + __shfl_xor(send, 32); }
#pragma unroll
            for (int i = 0; i < 4; ++i) { const bool hb = (L & 16) != 0; const float keep = hb ? r8[i + 4] : r8[i], send = hb ? r8[i] : r8[i + 4]; r4[i] = keep + __shfl_xor(send, 16); }
#pragma unroll
            for (int i = 0; i < 2; ++i) { const bool hb = (L & 8) != 0; const float keep = hb ? r4[i + 2] : r4[i], send = hb ? r4[i] : r4[i + 2]; r2[i] = keep + __shfl_xor(send, 8); }
            { const bool hb = (L & 4) != 0; const float keep = hb ? r2[1] : r2[0], send = hb ? r2[0] : r2[1]; r1 = keep + __shfl_xor(send, 4); }
            r1 += __shfl_xor(r1, 2); r1 += __shfl_xor(r1, 1);
            const int h = (L >> 2) & 15;
            const float z = r1 + b_f[h];
            const float ls = fminf(z, 0.f) - log1pf(__expf(-fabsf(z)));
            if ((L & 3) == 0) FLF[(size_t)(b * 16 + h) * SEQ + (m - b * SEQ)] = ls * 1.4426950408889634f;
        }
    }
}

__device__ __forceinline__ void final_norm(Frame& F0, float* xio, const float* g) {
    Frame F = F0; asm volatile("" : "+v"(F.tid)); F.lane = F.tid & 63;
    const int gw = F.vcu * NWAVES + F.wave, NGW = F.G * NWAVES;
    for (int m = gw; m < M; m += NGW) {
        GAS f32x4* xr = (GAS f32x4*)(xio + (size_t)m * D) + F.lane; const GAS f32x4* gr = (const GAS f32x4*)g + F.lane;
        f32x4 v[4]; float s = 0.f;
#pragma unroll
        for (int j = 0; j < 4; ++j) { v[j] = xr[64 * j]; s += (v[j].x * v[j].x + v[j].y * v[j].y) + (v[j].z * v[j].z + v[j].w * v[j].w); }
        const float rstd = 1.0f / sqrtf(wave_sum(s) * (1.f / D) + EPS);
#pragma unroll
        for (int j = 0; j < 4; ++j) xr[64 * j] = v[j] * rstd * gr[64 * j];
    }
}

__device__ __forceinline__ void fox_cum_to_lds(Frame& F0, const float* flf_bh, LAS float* cum) {
    Frame F = F0; asm volatile("" : "+v"(F.tid)); F.lane = F.tid & 63;
    LAS float* wsum = cum + SEQ;
    const GAS f32x4* src = (const GAS f32x4*)(flf_bh + 16 * F.tid);
    float p[16];
#pragma unroll
    for (int j = 0; j < 4; ++j) { const f32x4 t = src[j]; p[4 * j] = t.x; p[4 * j + 1] = t.y; p[4 * j + 2] = t.z; p[4 * j + 3] = t.w; }
#pragma unroll
    for (int i = 1; i < 16; ++i) p[i] += p[i - 1];
    float incl = p[15];
#pragma unroll
    for (int o = 1; o < 64; o <<= 1) { const float t = __shfl_up(incl, o); if (F.lane >= o) incl += t; }
    if (F.lane == 63) wsum[F.wave] = incl;
    __syncthreads();
    float off = incl - p[15];
    for (int w = 0; w < F.wave; ++w) off += wsum[w];
#pragma unroll
    for (int j = 0; j < 4; ++j) *(LAS f32x4*)(cum + 16 * F.tid + 4 * j) = (f32x4){p[4 * j] + off, p[4 * j + 1] + off, p[4 * j + 2] + off, p[4 * j + 3] + off};
    __syncthreads();
}
namespace hg {
typedef short v4i16_t __attribute__((ext_vector_type(4))); typedef unsigned u32x2 __attribute__((ext_vector_type(2)));
constexpr int RS = 272;
constexpr int PRS = 80;
constexpr int ORS = 528;
constexpr int L_QS = 0, L_QG = 8704, L_KS = 17408, L_KD = 26112, L_VV = 34816, L_PP = 43520, L_SB = 46080, L_OST = 80896, L_DD = 97792, L_PSUM = 98304, L_END = 100352;
static_assert(L_QG == 32 * RS && L_PP + 32 * PRS == L_SB && L_SB + 128 * RS == L_OST && L_OST + 32 * ORS == L_DD, "hgrn LDS map");

__device__ __forceinline__ bf16x8 frag_rm(LAS unsigned char* lds, int base, int rs, int row, int kk, int fq) {
    return *(const LAS bf16x8*)(lds + base + row * rs + kk * 64 + fq * 16);
}
__device__ __forceinline__ bf16x8 frag_tr(LAS unsigned char* lds, int base, int rs, int kbase, int nbase, int lane) {
    const int g = lane >> 4, q = (lane & 15) >> 2, p = lane & 3;
    LAS unsigned char* a = lds + base + (kbase + 8 * g + q) * rs + (nbase + 4 * p) * 2;
    const v4i16_t lo = __builtin_amdgcn_ds_read_tr16_b64_v4i16((LAS v4i16_t*)a);
    const v4i16_t hi = __builtin_amdgcn_ds_read_tr16_b64_v4i16((LAS v4i16_t*)(a + 4 * rs));
    return (bf16x8){lo[0], lo[1], lo[2], lo[3], hi[0], hi[1], hi[2], hi[3]};
}
__device__ __forceinline__ void st_bf16(LAS unsigned char* lds, int off, float v) { *(LAS unsigned short*)(lds + off) = (unsigned short)f2bf(v); }

template <bool FULL> __device__ __forceinline__ float gen_operands(LAS unsigned char* lds, int tid, size_t row0, int hcol, const bf16* HQ, const float* HLF, const bf16* HV) {
    const int c = tid & 127, part = tid >> 7;
    const float* lfp = HLF + (row0 + part * 8) * D + hcol + c;
    float lf[8]; float ps = 0.f;
#pragma unroll
    for (int i = 0; i < 8; ++i) { lf[i] = lfp[(size_t)i * D]; ps += lf[i]; }
    float qv[8];
    if (FULL) { const bf16* qp = HQ + (row0 + part * 8) * D + hcol + c;
#pragma unroll
        for (int i = 0; i < 8; ++i) qv[i] = bf2f(qp[(size_t)i * D]); }
    { const int r = tid >> 4, ch = tid & 15; const v4u vv = *(const GAS v4u*)(HV + (row0 + r) * D + hcol + ch * 8); *(LAS v4u*)(lds + L_VV + r * RS + ch * 16) = vv; }
    LAS float* psum = (LAS float*)(lds + L_PSUM);
    psum[part * 128 + c] = ps;
    __syncthreads();
    const float p0 = psum[c], p1 = psum[128 + c], p2 = psum[256 + c], p3 = psum[384 + c];
    const float gstart = part == 0 ? 0.f : part == 1 ? p0 : part == 2 ? p0 + p1 : (p0 + p1) + p2;
    const float gmid = p0 + p1, glast = (p0 + p1) + (p2 + p3);
    float G = gstart;
#pragma unroll
    for (int i = 0; i < 8; ++i) { const int t = part * 8 + i; G += lf[i];
        const float k = 1.0f - __expf(lf[i]);
        st_bf16(lds, L_KD + t * RS + c * 2, k * __expf(glast - G));
        if (FULL) { st_bf16(lds, L_KS + t * RS + c * 2, k * __expf(gmid - G)); st_bf16(lds, L_QS + t * RS + c * 2, qv[i] * __expf(G - gmid)); st_bf16(lds, L_QG + t * RS + c * 2, qv[i] * __expf(G)); } }
    if (part == 0) *(LAS float*)(lds + L_DD + c * 4) = __expf(glast);
    __syncthreads();
    return glast;
}
__device__ __forceinline__ void state_update(LAS unsigned char* lds, f32x4 (&st)[8], int w, int lane) {
    const int fr = lane & 15;
    const bf16x8 aV = frag_tr(lds, L_VV, RS, 0, 16 * w, lane);
#pragma unroll
    for (int ct = 0; ct < 8; ++ct) { const float dv = *(const LAS float*)(lds + L_DD + (16 * ct + fr) * 4);
        const bf16x8 bK = frag_tr(lds, L_KD, RS, 0, 16 * ct, lane);
        st[ct] = st[ct] * dv; st[ct] = __builtin_amdgcn_mfma_f32_16x16x32_bf16(aV, bK, st[ct], 0, 0, 0); }
}
__device__ __forceinline__ void write_state_copy(LAS unsigned char* lds, const f32x4 (&st)[8], int w, int lane) {
    const int fr = lane & 15, fq = lane >> 4;
#pragma unroll
    for (int ct = 0; ct < 8; ++ct) { u32x2 pk; pk.x = pk2(st[ct][0], st[ct][1]); pk.y = pk2(st[ct][2], st[ct][3]); *(LAS u32x2*)(lds + L_SB + (16 * ct + fr) * RS + (16 * w + 4 * fq) * 2) = pk; }
}

__device__ __forceinline__ void pass_a(Frame& F0, const float* HLF, const bf16* HV, float* HS, float* HDl) {
    Frame F = F0; asm volatile("" : "+v"(F.tid)); F.lane = F.tid & 63;
    LAS unsigned char* lds = F.lds; const int tid = F.tid, lane = F.lane, w = F.wave;
    for (int unit = F.vcu; unit < 256; unit += F.G) {
        const int bh = unit >> 4, j = unit & 15, b = bh >> 3, h = bh & 7;
        f32x4 st[8];
#pragma unroll
        for (int ct = 0; ct < 8; ++ct) st[ct] = (f32x4){0.f, 0.f, 0.f, 0.f};
        float dlog = 0.f;
#pragma unroll 1
        for (int ch = 0; ch < 16; ++ch) {
            const size_t row0 = (size_t)b * SEQ + j * 512 + ch * 32;
            dlog += gen_operands<false>(lds, tid, row0, h * 128, nullptr, HLF, HV);
            state_update(lds, st, w, lane);
            __syncthreads();
        }
        float* so = HS + (size_t)unit * 16384;
#pragma unroll
        for (int ct = 0; ct < 8; ++ct) *(GAS f32x4*)(so + ((w * 8 + ct) * 64 + lane) * 4) = st[ct];
        if (tid < 128) HDl[unit * 128 + tid] = dlog;
    }
}
__device__ __forceinline__ void combine(Frame& F0, float* HS, const float* HDl) {
    Frame F = F0; asm volatile("" : "+v"(F.tid)); F.lane = F.tid & 63;
    for (int it = F.vcu; it < 256; it += F.G) {
        const int bh = it >> 4, seg = it & 15;
        if (F.tid < 256) { const int e4 = seg * 256 + F.tid, ct = (e4 >> 6) & 7, c = 16 * ct + (e4 & 15);
            f32x4 S = (f32x4){0.f, 0.f, 0.f, 0.f};
#pragma unroll 4
            for (int j = 0; j < 16; ++j) { GAS f32x4* p = (GAS f32x4*)(HS + (size_t)(bh * 16 + j) * 16384) + e4; const f32x4 tmp = *p; const float dv = __expf(HDl[(bh * 16 + j) * 128 + c]); *p = S; S = S * dv + tmp; } }
    }
}
__device__ __forceinline__ void pass_c(Frame& F0, const bf16* HQ, const float* HLF, const bf16* HV, const bf16* HG, const float* HS, const float* gnorm, bf16* HO) {
    Frame F = F0; asm volatile("" : "+v"(F.tid)); F.lane = F.tid & 63;
    LAS unsigned char* lds = F.lds; const int tid = F.tid, lane = F.lane, w = F.wave, fr = lane & 15, fq = lane >> 4;
    for (int unit = F.vcu; unit < 256; unit += F.G) {
        const int bh = unit >> 4, j = unit & 15, b = bh >> 3, h = bh & 7, hcol = h * 128;
        f32x4 st[8];
        { const float* so = HS + (size_t)unit * 16384;
#pragma unroll
          for (int ct = 0; ct < 8; ++ct) st[ct] = *(const GAS f32x4*)(so + ((w * 8 + ct) * 64 + lane) * 4); }
        write_state_copy(lds, st, w, lane);
#pragma unroll 1
        for (int ch = 0; ch < 16; ++ch) {
            const size_t row0 = (size_t)b * SEQ + j * 512 + ch * 32;
            gen_operands<true>(lds, tid, row0, hcol, HQ, HLF, HV);
            if (w < 4) { const int stl = w >> 1, ttl = w & 1; f32x4 x = (f32x4){0.f, 0.f, 0.f, 0.f};
                if (stl <= ttl) {
#pragma unroll
                    for (int kk = 0; kk < 4; ++kk) { const bf16x8 a = frag_rm(lds, L_KS, RS, 16 * stl + fr, kk, fq), bq = frag_rm(lds, L_QS, RS, 16 * ttl + fr, kk, fq); x = __builtin_amdgcn_mfma_f32_16x16x32_bf16(a, bq, x, 0, 0, 0); }
                    const int t = 16 * ttl + fr;
#pragma unroll
                    for (int r = 0; r < 4; ++r) { const int s = 16 * stl + 4 * fq + r; if (s > t) x[r] = 0.f; } }
                u32x2 pk; pk.x = pk2(x[0], x[1]); pk.y = pk2(x[2], x[3]);
                *(LAS u32x2*)(lds + L_PP + (16 * ttl + fr) * PRS + (16 * stl + 4 * fq) * 2) = pk; }
            __syncthreads();
            f32x4 o[2];
            { const bf16x8 bV = frag_tr(lds, L_VV, RS, 0, 16 * w, lane);
              bf16x8 bS[4];
#pragma unroll
              for (int kk = 0; kk < 4; ++kk) bS[kk] = frag_tr(lds, L_SB, RS, 32 * kk, 16 * w, lane);
#pragma unroll
              for (int tt = 0; tt < 2; ++tt) { o[tt] = (f32x4){0.f, 0.f, 0.f, 0.f};
                  const bf16x8 aP = *(const LAS bf16x8*)(lds + L_PP + (16 * tt + fr) * PRS + fq * 16);
                  o[tt] = __builtin_amdgcn_mfma_f32_16x16x32_bf16(aP, bV, o[tt], 0, 0, 0);
#pragma unroll
                  for (int kk = 0; kk < 4; ++kk) { const bf16x8 aQ = frag_rm(lds, L_QG, RS, 16 * tt + fr, kk, fq); o[tt] = __builtin_amdgcn_mfma_f32_16x16x32_bf16(aQ, bS[kk], o[tt], 0, 0, 0); } } }
            state_update(lds, st, w, lane);
#pragma unroll
            for (int tt = 0; tt < 2; ++tt)
#pragma unroll
                for (int r = 0; r < 4; ++r) *(LAS float*)(lds + L_OST + (16 * tt + 4 * fq + r) * ORS + (16 * w + fr) * 4) = o[tt][r];
            __syncthreads();
            write_state_copy(lds, st, w, lane);
#pragma unroll
            for (int rr = 0; rr < 4; ++rr) { const int t = 4 * w + rr; const f32x2 ov = *(const LAS f32x2*)(lds + L_OST + t * ORS + lane * 8);
                const float ss = wave_sum(ov.x * ov.x + ov.y * ov.y); const float rstd = 1.0f / sqrtf(ss * (1.f / 128.f) + EPS);
                const size_t gi = (row0 + t) * D + hcol + 2 * lane; const unsigned gq = *(const GAS unsigned*)(HG + gi);
                const float g0 = gnorm[hcol + 2 * lane], g1 = gnorm[hcol + 2 * lane + 1];
                *(GAS unsigned*)(HO + gi) = pk2(ov.x * rstd * g0 * __uint_as_float(gq << 16), ov.y * rstd * g1 * __uint_as_float(gq & 0xffff0000u)); }
            __syncthreads();
        }
    }
}
}
struct Args { const float* in[15]; float* out; unsigned char* ws; };
#ifndef PHMASK
#define PHMASK 0xffff
#endif
#ifndef PG8_SP2
#define PG8_SP2 true
#endif
__global__ void __launch_bounds__(NWAVES * 64, 2) fwd_megakernel(Args args) {
    extern __shared__ __attribute__((aligned(16))) unsigned char lds[];
    Frame F;
    F.lds = (LAS unsigned char*)lds;
    F.MISC = (volatile LAS unsigned*)(F.lds + MISC_OFF);
    F.tid = threadIdx.x; F.lane = F.tid & 63; F.wave = __builtin_amdgcn_readfirstlane(F.tid >> 6);
    F.G = gridDim.x; { const int bx = blockIdx.x; F.vcu = (F.G % 8 == 0) ? (bx % 8) * (F.G / 8) + bx / 8 : bx; }
    Ptrs P;
    P.x = args.in[0]; P.c = args.in[1]; P.ada_w = args.in[2]; P.ada_b = args.in[3]; P.norm_g = args.in[4]; P.w_up = args.in[5]; P.w_dn = args.in[6]; P.fox_w_in = args.in[7]; P.fox_b_f = args.in[8];
    P.fox_w_out = args.in[9]; P.hgrn_w_in = args.in[10]; P.hgrn_norm_g = args.in[11]; P.hgrn_w_out = args.in[12]; P.lb_logits = args.in[13]; P.final_g = args.in[14]; P.out = args.out; P.ws = args.ws;
    unsigned char* ws = args.ws;
    F.ctl = (gu32*)(ws + WS_CTL);
    for (int u = F.tid; u < (LDS_BYTES - LDSCTL_OFF) / 4; u += NWAVES * 64) ((LAS unsigned*)(F.lds + LDSCTL_OFF))[u] = 0u;
    __syncthreads();
    XcdBarrier bar = xcd_barrier_post((unsigned*)(F.ctl + CW_BAR), F.MISC + 8);
#define GRID_BAR() xcd_barrier(bar)
    float* const mod = (float*)(ws + WS_MOD);
    bf16* const Hb = (bf16*)(ws + WS_H);
    bf16* const ACT = (bf16*)(ws + WS_ACT);
    float* const X = P.out;

    if (PHMASK & 1024) p0_prologue(F, P);
    GRID_BAR();

#pragma unroll 1
    for (int layer = 0; layer < DEPTH; ++layer) {
        const float* modl = mod + (size_t)layer * BATCH * NADA;
#pragma unroll 1
        for (int slot = 0; slot < 2; ++slot) {
            if (slot == 1) {
                const float* modm = modl + 1 * 3 * D;
                if (layer == 0) {
if (PHMASK & 1) {
                    norm_pass<true>(F, X, P.norm_g + (size_t)(layer * 3 + 1) * D, modm, Hb, P.fox_w_in, P.fox_b_f, (float*)(ws + WS_FLF));
}
                    GRID_BAR();
                    { pg8::Gemm g{Hb, (const bf16*)(ws + WS_WFIN), M, 4 * D, D}; pg8::StaticOrder S; S.init(M, 4 * D, F.G, (int)blockIdx.x);
                      pg8::EpiSplit4<0> E{(bf16*)(ws + WS_FQ), (size_t)(16 * MiB), nullptr, nullptr, attn_body::C2};
                      if (PHMASK & 16) pg8::gemm_phase<pg8::EpiSplit4<0>, pg8::StaticOrder, true, PG8_SP2>(F.lds + RING_OFF, g, S, E); }
                    GRID_BAR();
                    { const attn_body::StaticOrder S((int)F.G, (int)blockIdx.x);
                      LAS float* cum = (LAS float*)(F.lds + ATT_CUM_OFF);
                      fox_cum_to_lds(F, (const float*)(ws + WS_FLF) + (size_t)(S.vcu >> 3) * SEQ, cum);
                      const attn_body::AttnTensors AT{(const attn_body::bf16*)(ws + WS_FQ), (const attn_body::bf16*)(ws + WS_FK), (const attn_body::bf16*)(ws + WS_FV), (const attn_body::bf16*)(ws + WS_FG), (attn_body::bf16*)(ws + WS_FQ)};
if (PHMASK & 2) {
                      attn_body::attn_phase<attn_body::StaticOrder>((char*)lds + RING_OFF, AT, S, (attn_body::lds_cfptr)cum);
}
                    }
                    GRID_BAR();
                    { pg8::Gemm g{(const bf16*)(ws + WS_FQ), (const bf16*)(ws + WS_WFOUT), M, D, D}; pg8::StaticOrder S; S.init(M, D, F.G, (int)blockIdx.x);
                      pg8::EpiResGate E{X, X, D, modm + 2 * D, modm + NADA + 2 * D, 1.0f};
                      if (PHMASK & 128) pg8::gemm_phase<pg8::EpiResGate, pg8::StaticOrder, true, PG8_SP2>(F.lds + RING_OFF, g, S, E); }
                    GRID_BAR();
                } else {
                    norm_pass<false>(F, X, P.norm_g + (size_t)(layer * 3 + 1) * D, modm, Hb, nullptr, nullptr, nullptr);
                    GRID_BAR();
                    { pg8::Gemm g{Hb, (const bf16*)(ws + WS_WHIN), M, 4 * D, D}; pg8::StaticOrder S; S.init(M, 4 * D, F.G, (int)blockIdx.x);
                      pg8::EpiSplit4<1> E{(bf16*)(ws + WS_HQ), (size_t)(16 * MiB), (float*)(ws + WS_HLF), (const float*)(ws + WS_LB), 1.0f};
                      if (PHMASK & 32) pg8::gemm_phase<pg8::EpiSplit4<1>, pg8::StaticOrder, true, PG8_SP2>(F.lds + RING_OFF, g, S, E); }
                    GRID_BAR();
if (PHMASK & 4) {
                    hg::pass_a(F, (const float*)(ws + WS_HLF), (const bf16*)(ws + WS_HV), (float*)(ws + WS_HS), (float*)(ws + WS_HD));
}
                    GRID_BAR();
                    hg::combine(F, (float*)(ws + WS_HS), (const float*)(ws + WS_HD));
                    GRID_BAR();
if (PHMASK & 8) {
                    hg::pass_c(F, (const bf16*)(ws + WS_HQ), (const float*)(ws + WS_HLF), (const bf16*)(ws + WS_HV), (const bf16*)(ws + WS_HG), (const float*)(ws + WS_HS), P.hgrn_norm_g, (bf16*)(ws + WS_HO));
}
                    GRID_BAR();
                    { pg8::Gemm g{(const bf16*)(ws + WS_HO), (const bf16*)(ws + WS_WHOUT), M, D, D}; pg8::StaticOrder S; S.init(M, D, F.G, (int)blockIdx.x);
                      pg8::EpiResGate E{X, X, D, modm + 2 * D, modm + NADA + 2 * D, 1.0f};
                      if (PHMASK & 256) pg8::gemm_phase<pg8::EpiResGate, pg8::StaticOrder, true, PG8_SP2>(F.lds + RING_OFF, g, S, E); }
                    GRID_BAR();
                }
            }
            const int sub = slot * 2, wi = layer * 2 + slot;
            const float* modf = modl + (size_t)sub * 3 * D;
            const float* xin = (layer == 0 && slot == 0) ? P.x : X;
            norm_pass<false>(F, xin, P.norm_g + (size_t)(layer * 3 + sub) * D, modf, Hb, nullptr, nullptr, nullptr);
            GRID_BAR();
            { pg8::Gemm g{Hb, (const bf16*)(ws + WS_WUP + wi * WUP_BYTES), M, NUP, D}; pg8::StaticOrder S; S.init(M, NUP, F.G, (int)blockIdx.x);
              pg8::EpiSwiGLU E{ACT, FF};
              if (PHMASK & 64) pg8::gemm_phase<pg8::EpiSwiGLU, pg8::StaticOrder, true, PG8_SP2>(F.lds + RING_OFF, g, S, E); }
            GRID_BAR();
            { pg8::Gemm g{ACT, (const bf16*)(ws + WS_WDN + wi * WDN_BYTES), M, D, FF}; pg8::StaticOrder S; S.init(M, D, F.G, (int)blockIdx.x);
              pg8::EpiResGate E{xin, X, D, modf + 2 * D, modf + NADA + 2 * D, 0.5f};
              if (PHMASK & 512) pg8::gemm_phase<pg8::EpiResGate, pg8::StaticOrder, true, PG8_SP2>(F.lds + RING_OFF, g, S, E); }
            GRID_BAR();
        }
    }
    final_norm(F, X, P.final_g);
}

extern "C" void kernel_launch(void* const* d_in, const int* in_sizes, int n_in, void* d_out, int out_size, void* d_ws, size_t ws_size, hipStream_t stream) {
    static int grid = 0;
    if (grid == 0) {
        if (n_in != 15 || in_sizes[0] != M * D || out_size != M * D || ws_size < WS_END) { fprintf(stderr, "kernel_launch: built for 15 inputs, x and out of %d floats, >= %zu bytes of workspace; got n_in %d, in0 %d, out %d, ws %zu; nothing launched\n", M * D, (size_t)WS_END, n_in, n_in > 0 ? in_sizes[0] : -1, out_size, ws_size); grid = -1; return; }
        int dev = 0, cus = 0, per_cu = 0;
        if (hipGetDevice(&dev) != hipSuccess || hipDeviceGetAttribute(&cus, hipDeviceAttributeMultiprocessorCount, dev) != hipSuccess) { fprintf(stderr, "kernel_launch: hipGetDevice / hipDeviceGetAttribute failed\n"); grid = -1; return; }
        if (hipFuncSetAttribute((const void*)fwd_megakernel, hipFuncAttributeMaxDynamicSharedMemorySize, LDS_BYTES) != hipSuccess) { fprintf(stderr, "kernel_launch: hipFuncSetAttribute failed\n"); grid = -1; return; }
        if (hipOccupancyMaxActiveBlocksPerMultiprocessor(&per_cu, (const void*)fwd_megakernel, NWAVES * 64, LDS_BYTES) != hipSuccess || per_cu < 1)
            fprintf(stderr, "kernel_launch: note: the occupancy query reports %d workgroups per CU\n", per_cu);
        (void)hipGetLastError();
        grid = cus;
        if (grid != 256) fprintf(stderr, "kernel_launch: %d CUs; this kernel's unit maps assume 256\n", grid);
    }
    if (grid < 0) return;
    if (hipMemsetAsync((char*)d_ws + WS_CTL, 0, CTL_ZERO_BYTES, stream) != hipSuccess) { fprintf(stderr, "kernel_launch: hipMemsetAsync failed\n"); return; }
    Args a{};
    for (int i = 0; i < 15; ++i) a.in[i] = (const float*)d_in[i];
    a.out = (float*)d_out; a.ws = (unsigned char*)d_ws;
    hipLaunchKernelGGL(fwd_megakernel, dim3(grid), dim3(NWAVES * 64), LDS_BYTES, stream, a);
    const hipError_t le = hipPeekAtLastError();
    if (le != hipSuccess) fprintf(stderr, "kernel_launch: launch failed: %s\n", hipGetErrorName(le));
}
```

```cpp
#include <hip/hip_runtime.h>
#include <cstdio>
#include <cstdint>
namespace pg8 {
#define PG8_LAS __attribute__((address_space(3)))
typedef unsigned short bf16_t;
typedef short bf16x8 __attribute__((ext_vector_type(8)));
typedef float f32x4 __attribute__((ext_vector_type(4)));
typedef unsigned u32x4 __attribute__((ext_vector_type(4)));
constexpr int BM = 256, BK = 64, HALF = 128, HTB = HALF * BK * 2  , STAGE_BYTES = 8 * HTB, NXCD = 8, WGM = 8;

__host__ __device__ __forceinline__ int lds_byte(int r, int c) { const int st = (r >> 4) * 2 + (c >> 5), rr = r & 15, cc = c & 31, ob = rr * 64 + cc * 2; return st * 1024 + (ob ^ (((ob >> 9) & 1) << 5)); }
__host__ __device__ __forceinline__ void stage_rc(int b, int& R, int& C) { const int st = b / 1024, sb = b % 1024, swz = sb ^ (((sb >> 9) & 1) << 5); R = (st >> 1) * 16 + swz / 64; C = (st & 1) * 32 + (swz % 64) / 2; }
__host__ __device__ __forceinline__ int perm32(int rho) { const int n = rho >> 4, i = rho & 15; return 8 * (i >> 2) + 4 * n + (i & 3); }

struct Unit { int pm, pn; };
struct Gemm { const bf16_t* A; const bf16_t* Bt; int M, N, K; };

struct StaticOrder {
    int nM, nN, nwg, G, c;
    __host__ __device__ void init(int M, int N, int G_, int c_) { nM = M / BM; nN = N / BM; nwg = nM * nN; G = G_; c = c_; }
    __host__ __device__ bool next(int i, Unit& u) const {
        const long L = (long)i * G + c; if (L >= nwg) return false;
        int wgid = (int)L; { const int q = nwg / NXCD, r = nwg % NXCD, xcd = wgid % NXCD, off = wgid / NXCD; wgid = (xcd < r ? xcd * (q + 1) : r * (q + 1) + (xcd - r) * q) + off; }
        const int nig = WGM * nN, gid = wgid / nig, fm = gid * WGM, gsz = (nM - fm) < WGM ? (nM - fm) : WGM;
        u.pm = fm + ((wgid % nig) % gsz); u.pn = (wgid % nig) / gsz; return true;
    }
    __device__ __forceinline__ void a_ready(const Unit&) const {}
    __device__ __forceinline__ void done(const Unit&) const {}
};

__device__ __forceinline__ unsigned cvt_pk_bf16(float lo, float hi) { unsigned r; asm volatile("v_cvt_pk_bf16_f32 %0, %1, %2" : "=v"(r) : "v"(lo), "v"(hi)); return r; }
typedef float f32x2 __attribute__((ext_vector_type(2)));
__device__ __forceinline__ float sigmoid_f(float z) { return __builtin_amdgcn_rcpf(1.0f + __builtin_amdgcn_exp2f(-1.4426950408889634f * z)); }
__device__ __forceinline__ float silu_f(float z) { return z * sigmoid_f(z); }

struct EpiSwiGLU {
    static constexpr bool PERM = true, AFTER_DRAIN = false;
    bf16_t* O; int ldc;
    __device__ __forceinline__ void operator()(const f32x4 (&acc)[2][2][4][2], const Unit& u, int wr, int wc, int fr, int fq) const {
        const int row0 = u.pm * BM + wr * 64 + fr, col0 = u.pn * HALF + wc * 32 + 8 * fq;
#pragma unroll
        for (int ai = 0; ai < 2; ++ai)
#pragma unroll
            for (int m = 0; m < 4; ++m) { bf16_t* rowp = O + (size_t)(row0 + ai * HALF + m * 16) * ldc + col0;
                f32x4 v0, v1;
#pragma unroll
                for (int e = 0; e < 4; ++e) { v0[e] = silu_f(acc[ai][0][m][0][e]) * acc[ai][1][m][0][e]; v1[e] = silu_f(acc[ai][0][m][1][e]) * acc[ai][1][m][1][e]; }
                u32x4 w; w.x = cvt_pk_bf16(v0[0], v0[1]); w.y = cvt_pk_bf16(v0[2], v0[3]); w.z = cvt_pk_bf16(v1[0], v1[1]); w.w = cvt_pk_bf16(v1[2], v1[3]);
                *(u32x4*)rowp = w; asm volatile("" ::: "memory"); }
    }
};

struct EpiResGate {
    static constexpr bool PERM = false, AFTER_DRAIN = false;
    const float* base; float* out; int ldc; const float* gate0; const float* gate1; float coef;
    __device__ __forceinline__ void operator()(const f32x4 (&acc)[2][2][4][2], const Unit& u, int wr, int wc, int fr, int fq) const {
        const float* gp = (u.pm >= 32) ? gate1 : gate0;
        const int col0 = u.pn * BM + wc * 32 + 4 * fq;
#pragma unroll
        for (int ai = 0; ai < 2; ++ai)
#pragma unroll
            for (int m = 0; m < 4; ++m) { const size_t off = (size_t)(u.pm * BM + ai * HALF + wr * 64 + m * 16 + fr) * ldc + col0;
#pragma unroll
                for (int bj = 0; bj < 2; ++bj)
#pragma unroll
                    for (int n = 0; n < 2; ++n) { const f32x4 gv = *(const f32x4*)(gp + col0 + bj * HALF + n * 16) * coef; const f32x4 bs = *(const f32x4*)(base + off + bj * HALF + n * 16); *(f32x4*)(out + off + bj * HALF + n * 16) = bs + acc[ai][bj][m][n] * gv; }
                asm volatile("" ::: "memory"); }
    }
};

template <int MODE> struct EpiSplit4 {
    static constexpr bool PERM = true, AFTER_DRAIN = false;
    bf16_t* O0; size_t ostride; float* F1; const float* lb; float scale0; unsigned* stat;
    __device__ __forceinline__ void operator()(const f32x4 (&acc)[2][2][4][2], const Unit& u, int wr, int wc, int fr, int fq) const {
        const int t = u.pn >> 2, row0 = u.pm * BM + wr * 64 + fr, col0 = (u.pn & 3) * BM + wc * 32 + 8 * fq;
        bf16_t* Ob = O0 + (size_t)t * ostride;
        if (MODE == 1 && t == 1) {
#pragma unroll
            for (int ai = 0; ai < 2; ++ai)
#pragma unroll
                for (int m = 0; m < 4; ++m) { float* rowp = F1 + (size_t)(row0 + ai * HALF + m * 16) * 1024 + col0;
#pragma unroll
                    for (int bj = 0; bj < 2; ++bj)
#pragma unroll
                        for (int n = 0; n < 2; ++n) { f32x4 o; const f32x4 lbv = *(const f32x4*)(lb + col0 + bj * HALF + 4 * n);
#pragma unroll
                            for (int e = 0; e < 4; ++e) { const float l = lbv[e]; o[e] = __logf(l + (1.0f - l) * sigmoid_f(acc[ai][bj][m][n][e])); }
                            *(f32x4*)(rowp + bj * HALF + 4 * n) = o; }
                    asm volatile("" ::: "memory"); }
            return;
        }
        const int act = (MODE == 0) ? (t == 3 ? 1 : 0) : (t >= 2 ? 2 : 0);
        const float sc = (MODE == 0 && t == 0) ? scale0 : 1.0f;
        float mx[2] = {0.f, 0.f};
#pragma unroll
        for (int ai = 0; ai < 2; ++ai)
#pragma unroll
            for (int m = 0; m < 4; ++m) { bf16_t* rowp = Ob + (size_t)(row0 + ai * HALF + m * 16) * 1024 + col0;
#pragma unroll
                for (int bj = 0; bj < 2; ++bj) { f32x4 v0 = acc[ai][bj][m][0], v1 = acc[ai][bj][m][1];
                    if (act == 1) {
#pragma unroll
                        for (int e = 0; e < 4; ++e) { v0[e] = sigmoid_f(v0[e]); v1[e] = sigmoid_f(v1[e]); } }
                    else if (act == 2) {
#pragma unroll
                        for (int e = 0; e < 4; ++e) { v0[e] = silu_f(v0[e]); v1[e] = silu_f(v1[e]); } }
                    v0 = v0 * sc; v1 = v1 * sc;
                    u32x4 w; w.x = cvt_pk_bf16(v0[0], v0[1]); w.y = cvt_pk_bf16(v0[2], v0[3]); w.z = cvt_pk_bf16(v1[0], v1[1]); w.w = cvt_pk_bf16(v1[2], v1[3]);
                    if (MODE == 0 && t < 2) { float s2 = ((v0[0] * v0[0] + v0[1] * v0[1]) + (v0[2] * v0[2] + v0[3] * v0[3])) + ((v1[0] * v1[0] + v1[1] * v1[1]) + (v1[2] * v1[2] + v1[3] * v1[3])); s2 += __shfl_xor(s2, 16); s2 += __shfl_xor(s2, 32); mx[bj] = fmaxf(mx[bj], s2); }
                    *(u32x4*)(rowp + bj * HALF) = w; }
                asm volatile("" ::: "memory"); }
        if (MODE == 0 && t < 2) {
#pragma unroll
            for (int bj = 0; bj < 2; ++bj) { float m_ = mx[bj];
#pragma unroll
                for (int o = 1; o < 64; o <<= 1) m_ = fmaxf(m_, __shfl_xor(m_, o));
                if ((fr | fq) == 0) atomicMax(stat + ((((u.pm >= 32) ? 16 : 0) + (u.pn & 3) * 4 + 2 * bj + (wc >> 1)) * 2 + t), __float_as_uint(m_)); } }
    }
};
template <class Epi, class Sched, bool ALIGN_EPI = false, bool SP2 = false>
__device__ __forceinline__ void gemm_phase(PG8_LAS unsigned char* lds, const Gemm g, const Sched& S, const Epi& E) {
    int tid_ = threadIdx.x; asm volatile("" : "+v"(tid_));
    const int tid = tid_, wid = __builtin_amdgcn_readfirstlane(tid >> 6), lane = tid & 63, wr = wid >> 2, wc = wid & 3, fr = lane & 15, fq = lane >> 4;
    const int K = g.K, nt = K / BK;
    unsigned voffA[2], voffB[2];
#pragma unroll
    for (int i = 0; i < 2; ++i) { int R, C; stage_rc(tid * 16 + i * 8192, R, C); const int Rb = Epi::PERM ? ((R & ~31) + perm32(R & 31)) : R;
        voffA[i] = (unsigned)(R * K + C) * 2u; voffB[i] = (unsigned)(Rb * K + C) * 2u; }
    const size_t kstep = (size_t)(BK * 2);
    const size_t hstep = (size_t)HALF * K * 2;
    const size_t tstep = 2 * hstep;
    const unsigned ldsw = (unsigned)wid * 1024u;
    const int aoff = lds_byte(wr * 64 + fr, fq * 8), boff = lds_byte(wc * 32 + fr, fq * 8);
#define PG8_SA(b, h) (((b) * 2 + (h)) * HTB)
#define PG8_SB(b, h) ((4 + (b) * 2 + (h)) * HTB)
#define PG8_STAGE(bufoff, gbase, voff) do { _Pragma("unroll") for (int _i = 0; _i < 2; ++_i) \
        __builtin_amdgcn_global_load_lds((const unsigned*)((const char*)(gbase) + (voff)[_i]), (PG8_LAS unsigned*)(lds + (bufoff) + ldsw + _i * 8192), 16, 0, 0); } while (0)
#define PG8_LDA(dst, b, h) do { _Pragma("unroll") for (int m = 0; m < 4; ++m) _Pragma("unroll") for (int k = 0; k < 2; ++k) dst[m][k] = *(const PG8_LAS bf16x8*)(lds + PG8_SA(b, h) + aoff + m * 2048 + k * 1024); } while (0)
#define PG8_LDB(dst, b, h) do { _Pragma("unroll") for (int n = 0; n < 2; ++n) _Pragma("unroll") for (int k = 0; k < 2; ++k) dst[n][k] = *(const PG8_LAS bf16x8*)(lds + PG8_SB(b, h) + boff + n * 2048 + k * 1024); } while (0)
#define PG8_MMA(ai, bj, At, Bt) do { __builtin_amdgcn_s_setprio(1); _Pragma("unroll") for (int m = 0; m < 4; ++m) _Pragma("unroll") for (int n = 0; n < 2; ++n) _Pragma("unroll") for (int k = 0; k < 2; ++k) \
        acc[ai][bj][m][n] = __builtin_amdgcn_mfma_f32_16x16x32_bf16(Bt[n][k], At[m][k], acc[ai][bj][m][n], 0, 0, 0); __builtin_amdgcn_s_setprio(0); } while (0)
#define PG8_WAIT_V(n) asm volatile("s_waitcnt vmcnt(" #n ")" ::: "memory")
#define PG8_WAIT_L(n) asm volatile("s_waitcnt lgkmcnt(" #n ")" ::: "memory")
#define PG8_BAR __builtin_amdgcn_s_barrier()
#define PG8_SCHED __builtin_amdgcn_sched_barrier(0)
    Unit cur, nxt; int ui = 0;
    if (!S.next(0, cur)) return;
    f32x4 acc[2][2][4][2];
#pragma unroll
    for (int a = 0; a < 2; ++a)
#pragma unroll
        for (int b = 0; b < 2; ++b)
#pragma unroll
            for (int m = 0; m < 4; ++m)
#pragma unroll
                for (int n = 0; n < 2; ++n) acc[a][b][m][n] = (f32x4){0.f, 0.f, 0.f, 0.f};
    bf16x8 At[4][2], B0[2][2], B1[2][2];
    const char* cA = (const char*)g.A + (size_t)cur.pm * tstep; const char* cB = (const char*)g.Bt + (size_t)cur.pn * tstep;
    S.a_ready(cur);
    if constexpr (SP2) {
        PG8_STAGE(PG8_SB(0, 0), cB, voffB); PG8_STAGE(PG8_SB(0, 1), cB + hstep, voffB); PG8_STAGE(PG8_SA(0, 0), cA, voffA); PG8_STAGE(PG8_SA(0, 1), cA + hstep, voffA);
        if (wr == 1) PG8_BAR;
        PG8_WAIT_V(2); PG8_BAR;
        PG8_STAGE(PG8_SB(1, 0), cB + kstep, voffB); PG8_STAGE(PG8_SA(1, 0), cA + kstep, voffA); PG8_STAGE(PG8_SB(1, 1), cB + hstep + kstep, voffB);
        PG8_WAIT_V(6); PG8_BAR;
    } else {
        PG8_STAGE(PG8_SB(0, 0), cB, voffB); PG8_STAGE(PG8_SA(0, 0), cA, voffA); PG8_STAGE(PG8_SB(0, 1), cB + hstep, voffB); PG8_STAGE(PG8_SA(0, 1), cA + hstep, voffA);
        if (wr == 1) PG8_BAR;
        PG8_WAIT_V(4); PG8_BAR;
        PG8_STAGE(PG8_SB(1, 0), cB + kstep, voffB); PG8_STAGE(PG8_SA(1, 0), cA + kstep, voffA); PG8_STAGE(PG8_SB(1, 1), cB + hstep + kstep, voffB);
        PG8_WAIT_V(6); PG8_BAR;
    }
    for (;;) {
        const bool has_next = S.next(ui + 1, nxt);
        const char* nA = has_next ? (const char*)g.A + (size_t)nxt.pm * tstep : cA; const char* nB = has_next ? (const char*)g.Bt + (size_t)nxt.pn * tstep : cB;
        for (int t = 0; t < nt; t += 2) {
            const bool last = (t == nt - 2);
            const char* a1 = cA + (size_t)(t + 1) * kstep;
            const char* a2 = last ? nA : cA + (size_t)(t + 2) * kstep; const char* b2 = last ? nB : cB + (size_t)(t + 2) * kstep;
            const char* a3 = a2 + kstep; const char* b3 = b2 + kstep;
            if (last && has_next) S.a_ready(nxt);
            if constexpr (SP2) {
            PG8_LDB(B0, 0, 0); PG8_LDB(B1, 0, 1); PG8_SCHED; PG8_LDA(At, 0, 0); PG8_STAGE(PG8_SA(1, 1), a1 + hstep, voffA);
            PG8_WAIT_V(8); PG8_WAIT_L(0); PG8_BAR; PG8_MMA(0, 0, At, B0); PG8_MMA(0, 1, At, B1); PG8_BAR; PG8_SCHED;
            PG8_LDA(At, 0, 1); PG8_STAGE(PG8_SB(0, 0), b2, voffB); PG8_STAGE(PG8_SB(0, 1), b2 + hstep, voffB); PG8_STAGE(PG8_SA(0, 0), a2, voffA);
            PG8_WAIT_V(8); PG8_WAIT_L(0); PG8_BAR; PG8_MMA(1, 0, At, B0); PG8_MMA(1, 1, At, B1); PG8_BAR; PG8_SCHED;
            PG8_LDB(B0, 1, 0); PG8_LDB(B1, 1, 1); PG8_SCHED; PG8_LDA(At, 1, 0); PG8_STAGE(PG8_SA(0, 1), a2 + hstep, voffA);
            PG8_WAIT_V(8); PG8_WAIT_L(0); PG8_BAR; PG8_MMA(0, 0, At, B0); PG8_MMA(0, 1, At, B1); PG8_BAR; PG8_SCHED;
            PG8_LDA(At, 1, 1); PG8_STAGE(PG8_SB(1, 0), b3, voffB); PG8_STAGE(PG8_SB(1, 1), b3 + hstep, voffB); PG8_STAGE(PG8_SA(1, 0), a3, voffA);
            PG8_WAIT_V(8); PG8_WAIT_L(0); PG8_BAR; PG8_MMA(1, 0, At, B0); PG8_MMA(1, 1, At, B1); PG8_BAR; PG8_SCHED;
            } else {
            PG8_LDB(B0, 0, 0); PG8_SCHED; PG8_LDA(At, 0, 0); PG8_STAGE(PG8_SA(1, 1), a1 + hstep, voffA);
            PG8_WAIT_L(8); PG8_BAR; PG8_WAIT_L(0); PG8_MMA(0, 0, At, B0); PG8_BAR; PG8_SCHED;
            PG8_LDB(B1, 0, 1); PG8_STAGE(PG8_SB(0, 0), b2, voffB);
            PG8_BAR; PG8_WAIT_L(0); PG8_MMA(0, 1, At, B1); PG8_BAR;
            PG8_LDA(At, 0, 1); PG8_STAGE(PG8_SA(0, 0), a2, voffA);
            PG8_BAR; PG8_WAIT_L(0); PG8_MMA(1, 0, At, B0); PG8_BAR; PG8_SCHED;
            PG8_STAGE(PG8_SB(0, 1), b2 + hstep, voffB);
            PG8_WAIT_V(6); PG8_BAR; PG8_MMA(1, 1, At, B1); PG8_BAR;
            PG8_LDB(B0, 1, 0); PG8_SCHED; PG8_LDA(At, 1, 0); PG8_STAGE(PG8_SA(0, 1), a2 + hstep, voffA);
            PG8_WAIT_L(8); PG8_BAR; PG8_WAIT_L(0); PG8_MMA(0, 0, At, B0); PG8_BAR; PG8_SCHED;
            PG8_LDB(B1, 1, 1); PG8_STAGE(PG8_SB(1, 0), b3, voffB);
            PG8_BAR; PG8_WAIT_L(0); PG8_MMA(0, 1, At, B1); PG8_BAR;
            PG8_LDA(At, 1, 1); PG8_STAGE(PG8_SA(1, 0), a3, voffA);
            PG8_BAR; PG8_WAIT_L(0); PG8_MMA(1, 0, At, B0); PG8_BAR; PG8_SCHED;
            PG8_STAGE(PG8_SB(1, 1), b3 + hstep, voffB);
            PG8_WAIT_V(6); PG8_BAR; PG8_MMA(1, 1, At, B1); PG8_BAR;
            }
        }
        if constexpr (ALIGN_EPI) { if (wr == 0) PG8_BAR; }
        if constexpr (!Epi::AFTER_DRAIN) { E(acc, cur, wr, wc, fr, fq); S.done(cur); }
        if (!has_next) break;
#pragma unroll
        for (int a = 0; a < 2; ++a)
#pragma unroll
            for (int b = 0; b < 2; ++b)
#pragma unroll
                for (int m = 0; m < 4; ++m)
#pragma unroll
                    for (int n = 0; n < 2; ++n) acc[a][b][m][n] = (f32x4){0.f, 0.f, 0.f, 0.f};
        cur = nxt; cA = nA; cB = nB; ++ui;
        if constexpr (ALIGN_EPI) { if (wr == 1) PG8_BAR; }
    }
    PG8_WAIT_V(0);
    if constexpr (!ALIGN_EPI) { if (wr == 0) PG8_BAR; }
    PG8_BAR;
    if constexpr (Epi::AFTER_DRAIN) { E.fused(acc, cur, wr, wc, fr, fq, lds, wid, lane); S.done(cur); }
#undef PG8_SA
#undef PG8_SB
#undef PG8_STAGE
#undef PG8_LDA
#undef PG8_LDB
#undef PG8_MMA
#undef PG8_WAIT_V
#undef PG8_WAIT_L
#undef PG8_BAR
#undef PG8_SCHED
}
}

#ifndef PG8_SP2
#define PG8_SP2 true
#endif
#ifndef PG8_ALIGN
#define PG8_ALIGN true
#endif
#include <hip/hip_bf16.h>
#include <cmath>
namespace attn_body {
using bf16=__hip_bfloat16;
using bf16x8=__attribute__((ext_vector_type(8)))short;
using s16x4=__attribute__((ext_vector_type(4)))short;
using f32x16=__attribute__((ext_vector_type(16)))float;
using u32x4=__attribute__((ext_vector_type(4)))unsigned;
constexpr int BATCH=2,NHEAD=16,SEQ=8192,D=64,DM=NHEAD*D;
constexpr int NW=8,QBLK=32,QB=QBLK*NW,KVBLK=64,NQB=SEQ/QB;
constexpr int ATTN_PITCH=DM, ATTN_UNIT_ROWS=QB;
__device__ __forceinline__ int crow(int r,int hi){return (r&3)+8*(r>>2)+4*hi;}
#define SBAR() __builtin_amdgcn_sched_barrier(0)
__device__ __forceinline__ void cmask(f32x16&p0,f32x16&p1,int jb,int qrel,int hi){
  const float NEG=-INFINITY; int kb=64*jb+4*hi;
  #pragma unroll
  for(int r=0;r<16;++r){int kv=kb+(r&3)+8*(r>>2); if(kv>qrel)p0[r]=NEG; if(kv+32>qrel)p1[r]=NEG;}
}

constexpr int NSLOT=3, SLOTB=8192;
constexpr int LDS_K=0, LDS_V=NSLOT*SLOTB, LDS_WS=2*NSLOT*SLOTB, LDS_OST=LDS_WS+NW*64*4, LDS_BYTES=LDS_OST+NW*4096;
constexpr float C2=0.125f*1.4426950408889634f;
__device__ __forceinline__ void glds16(const void*gsrc,unsigned lds_dst){unsigned keep;
  asm volatile("s_mov_b32 %0, m0\n\ts_mov_b32 m0, %2\n\ts_nop 0\n\tglobal_load_lds_dwordx4 %1, off\n\ts_mov_b32 m0, %0":"=&s"(keep):"v"(gsrc),"s"(lds_dst):"memory");}
__device__ __forceinline__ float max3f(float a,float b,float c){float r;asm("v_max3_f32 %0, %1, %2, %3":"=v"(r):"v"(a),"v"(b),"v"(c));return r;}
__device__ __forceinline__ float max2f(float a,float b){float r;asm("v_max_f32_e32 %0, %1, %2":"=v"(r):"v"(a),"v"(b));return r;}
__device__ __forceinline__ float fadd_s(float a,float b){float r;asm("v_add_f32_e32 %0, %1, %2":"=v"(r):"v"(a),"v"(b));return r;}
__device__ __forceinline__ float fsub_s(float a,float b){float r;asm("v_sub_f32_e32 %0, %1, %2":"=v"(r):"v"(a),"v"(b));return r;}
typedef float f32x2_t __attribute__((ext_vector_type(2))); typedef float f32x4_t __attribute__((ext_vector_type(4))); typedef __bf16 bf16x2_t __attribute__((ext_vector_type(2)));
__device__ __forceinline__ unsigned cvtpk_s(float lo,float hi){f32x2_t v={lo,hi};bf16x2_t b=__builtin_convertvector(v,bf16x2_t);return __builtin_bit_cast(unsigned,b);}
#define WAIT_BAR(N) asm volatile("s_waitcnt vmcnt(" #N ") lgkmcnt(0)\n\ts_barrier":::"memory")

__device__ __forceinline__ void qkt(f32x16&p0,f32x16&p1,const char*Kslot,const bf16x8*qr,const f32x16&negm,int r32,int hi){
  const char*kb=Kslot+hi*1024+r32*16;
  #pragma unroll
  for(int d0=0;d0<4;++d0){
    const bf16x8 b0=*reinterpret_cast<const bf16x8*>(kb+d0*2048);
    const bf16x8 b1=*reinterpret_cast<const bf16x8*>(kb+d0*2048+512);
    if(d0==0){p0=__builtin_amdgcn_mfma_f32_32x32x16_bf16(b0,qr[0],negm,0,0,0);p1=__builtin_amdgcn_mfma_f32_32x32x16_bf16(b1,qr[0],negm,0,0,0);}
    else{p0=__builtin_amdgcn_mfma_f32_32x32x16_bf16(b0,qr[d0],p0,0,0,0);p1=__builtin_amdgcn_mfma_f32_32x32x16_bf16(b1,qr[d0],p1,0,0,0);}}
}
typedef __attribute__((address_space(3))) const char* lds_cptr;
typedef short v4i16_t __attribute__((ext_vector_type(4)));
__device__ __forceinline__ void kload8(bf16x8*kf,lds_cptr kp){
  kf[0]=*(const __attribute__((address_space(3))) bf16x8*)(kp);      kf[1]=*(const __attribute__((address_space(3))) bf16x8*)(kp+512);
  kf[2]=*(const __attribute__((address_space(3))) bf16x8*)(kp+2048); kf[3]=*(const __attribute__((address_space(3))) bf16x8*)(kp+2560);
  kf[4]=*(const __attribute__((address_space(3))) bf16x8*)(kp+4096); kf[5]=*(const __attribute__((address_space(3))) bf16x8*)(kp+4608);
  kf[6]=*(const __attribute__((address_space(3))) bf16x8*)(kp+6144); kf[7]=*(const __attribute__((address_space(3))) bf16x8*)(kp+6656);
}
__device__ __forceinline__ void kload2(bf16x8*kf,lds_cptr kp,int j){ kf[2*j]=*(const __attribute__((address_space(3))) bf16x8*)(kp+j*2048); kf[2*j+1]=*(const __attribute__((address_space(3))) bf16x8*)(kp+j*2048+512); }
__device__ __forceinline__ s16x4 vtr(lds_cptr p){ return __builtin_bit_cast(s16x4,__builtin_amdgcn_ds_read_tr16_b64_v4i16((__attribute__((address_space(3))) v4i16_t*)p)); }
__device__ __forceinline__ float rowmax(const f32x16&p0,const f32x16&p1){
  float a=max3f(p0[0],p0[1],p1[0]),b=max3f(p0[2],p0[3],p1[1]);a=max3f(a,p1[2],p1[3]);
  #pragma unroll
  for(int r=4;r<16;r+=4){a=max3f(a,p0[r],p0[r+1]);b=max3f(b,p0[r+2],p0[r+3]);a=max3f(a,p1[r],p1[r+1]);b=max3f(b,p1[r+2],p1[r+3]);}
  const float m=max2f(a,b);
  auto rr=__builtin_amdgcn_permlane32_swap(__float_as_uint(m),__float_as_uint(m),false,false);
  return max2f(__uint_as_float(rr[0]),__uint_as_float(rr[1]));
}
__device__ __forceinline__ void pv(f32x16*o,int vb,bf16x8 pa0,bf16x8 pa1,bf16x8 pa2,bf16x8 pa3){
  #pragma unroll
  for(int d0=0;d0<2;++d0){s16x4 lo[4],hi[4];
    #pragma unroll
    for(int ks=0;ks<4;++ks){
      asm volatile("ds_read_b64_tr_b16 %0,%1 offset:%c2":"=&v"(lo[ks]):"v"(vb),"i"(d0*4096+ks*1024):"memory");
      asm volatile("ds_read_b64_tr_b16 %0,%1 offset:%c2":"=&v"(hi[ks]):"v"(vb),"i"(d0*4096+ks*1024+512):"memory");}
    asm volatile("s_waitcnt lgkmcnt(0)":::"memory");SBAR();
    #define PK(k) (bf16x8){lo[k][0],lo[k][1],lo[k][2],lo[k][3],hi[k][0],hi[k][1],hi[k][2],hi[k][3]}
    o[d0]=__builtin_amdgcn_mfma_f32_32x32x16_bf16(pa0,PK(0),o[d0],0,0,0);
    o[d0]=__builtin_amdgcn_mfma_f32_32x32x16_bf16(pa1,PK(1),o[d0],0,0,0);
    o[d0]=__builtin_amdgcn_mfma_f32_32x32x16_bf16(pa2,PK(2),o[d0],0,0,0);
    o[d0]=__builtin_amdgcn_mfma_f32_32x32x16_bf16(pa3,PK(3),o[d0],0,0,0);
    #undef PK
  }
}

#ifndef ATTN_STORE16
#define ATTN_STORE16(p,v) (*(u32x4*)(p)=(v))
#endif
typedef __attribute__((address_space(3))) const float* lds_cfptr;
#define FOXBIAS(C0,C1,t) do{ const lds_cfptr cb_=cumL+64*(t)+4*hi; \
    _Pragma("unroll") for(int g_=0;g_<4;++g_){ const f32x4_t b0_=*(const __attribute__((address_space(3))) f32x4_t*)(cb_+8*g_); const f32x4_t b1_=*(const __attribute__((address_space(3))) f32x4_t*)(cb_+32+8*g_); \
      _Pragma("unroll") for(int e_=0;e_<4;++e_){ C0[4*g_+e_]-=(b0_[e_]+mhat); C1[4*g_+e_]-=(b1_[e_]+mhat); } } }while(0)
template<int THRL> __device__ __forceinline__ void attn_unit(int b,int h,int qb,const bf16*Q,const bf16*__restrict__ K,const bf16*__restrict__ V,const bf16*__restrict__ Gt,bf16*O,char*shm,lds_cfptr cumL0,int t0){
  int tid_=threadIdx.x; asm volatile("":"+v"(tid_)); const int tid=tid_,lane=tid&63,r32=lane&31,hi=lane>>5; const int wid=__builtin_amdgcn_readfirstlane(tid>>6);
  const long rowbase=(long)b*SEQ; const int q0=qb*QB;
  const bf16*Qw=Q+(rowbase+q0+wid*QBLK)*DM+h*D;
  const bf16*Kh=K+(rowbase+(long)t0*KVBLK)*DM+h*D,*Vh=V+(rowbase+(long)t0*KVBLK)*DM+h*D; const lds_cfptr cumL=cumL0+t0*KVBLK;
  const unsigned lds0=(unsigned)(uintptr_t)shm;
  float*wsf=(float*)(shm+LDS_WS)+wid*64;
  const bf16*ksrc=Kh+(long)lane*DM+wid*8;
  const bf16*vsrc=Vh+(long)(16*(wid&3)+(lane>>2))*DM+(wid>>2)*32+(lane&3)*8;
  const unsigned kdst=lds0+LDS_K+wid*1024, vdst=lds0+LDS_V+wid*1024;
  #define DMA_K(t,slot) glds16(ksrc+(long)(t)*KVBLK*DM,(unsigned)__builtin_amdgcn_readfirstlane(kdst+(slot)))
  #define DMA_V(t,slot) glds16(vsrc+(long)(t)*KVBLK*DM,(unsigned)__builtin_amdgcn_readfirstlane(vdst+(slot)))
  const int vb0=(int)(lds0+LDS_V)+((lane>>4)&1)*32+(lane&3)*8+(4*hi+((lane&15)>>2))*64;
  const char*Kbase=shm+LDS_K; bf16x8 kf[8];
  const lds_cptr shm3=(lds_cptr)shm; const lds_cptr kp0=shm3+LDS_K+hi*1024+r32*16; const lds_cptr vp0=shm3+LDS_V+((lane>>4)&1)*32+(lane&3)*8+(4*hi+((lane&15)>>2))*64;
  const int NT=(q0+QB)/KVBLK-t0;
  DMA_K(0,0);DMA_V(0,0);DMA_K(1,SLOTB);
  bf16x8 qr[4];
  #pragma unroll
  for(int d0=0;d0<4;++d0)qr[d0]=*reinterpret_cast<const bf16x8*>(&Qw[(long)r32*DM+d0*16+hi*8]);
  const float cbq=cumL0[qb*QB+wid*QBLK+r32];
  float mhat=-cbq,l_reg=0.f;f32x16 o[2];o[0]=f32x16{};o[1]=f32x16{};const f32x16 negm=f32x16{};
  const int qrel=wid*QBLK+r32;
  #define CMASK(P0,P1,t) do{int jb_=(t)-(NT-4); if(jb_>=0)cmask(P0,P1,jb_,qrel,hi);}while(0)
  bool resc=false;
  #define START(P0,P1) do{ const float rm=rowmax(P0,P1); resc=false; \
    { const float dl=rm; mhat=fadd_s(mhat,dl); \
      _Pragma("unroll") for(int r=0;r<16;++r){P0[r]=fsub_s(P0[r],dl);P1[r]=fsub_s(P1[r],dl);} \
      } \
    _Pragma("unroll") for(int r=0;r<16;++r)P0[r]=__builtin_amdgcn_exp2f(P0[r]); }while(0)
  #define RESC() do{ if(resc){ asm volatile("s_waitcnt lgkmcnt(0)":::"memory"); \
      _Pragma("unroll") for(int d_=0;d_<2;++d_) _Pragma("unroll") for(int r=0;r<16;++r)o[d_][r]*=wsf[crow(r,hi)]; } }while(0)
  f32x16 pA0,pA1,pB0,pB1;
  int sl_prev=0,sl_cur=0,sl_next=SLOTB;
  #define ROT() do{sl_prev=sl_cur;sl_cur=sl_next;sl_next=(sl_next==(NSLOT-1)*SLOTB)?0:sl_next+SLOTB;}while(0)
  DMA_K(2,2*SLOTB);
  WAIT_BAR(3);
  qkt(pA0,pA1,Kbase,qr,negm,r32,hi);asm volatile("s_nop 15\n\ts_nop 7":"+v"(pA0),"+v"(pA1));FOXBIAS(pA0,pA1,0);CMASK(pA0,pA1,0);
  START(pA0,pA1);
  _Pragma("unroll") for(int r=0;r<16;++r)pA1[r]=__builtin_amdgcn_exp2f(pA1[r]);
  WAIT_BAR(0);
  DMA_K(3,0);DMA_V(1,SLOTB);
  ROT();
  kload8(kf,kp0+sl_cur);
  WAIT_BAR(2);
  s16x4 vlo[8],vhi[8]; u32x4 pw0,pw1,pw2,pw3;
  #define PKW(P,B) cvtpk_s(P[B],P[B+1])
  #define PAF(k) __builtin_bit_cast(bf16x8,pw##k)
  #define VFR(i) (bf16x8){vlo[i][0],vlo[i][1],vlo[i][2],vlo[i][3],vhi[i][0],vhi[i][1],vhi[i][2],vhi[i][3]}
  #define PIN(x) asm volatile("":"+v"(x))
  #define MX3(a,b,c) __builtin_fmaxf(__builtin_fmaxf((a),(b)),(c))
  #define GAPA(MF,A0,A1,A2,A3,W0,W1,PW) do{ MF; sacc+=A0; sacc+=A1; sacc+=A2; sacc+=A3; PIN(sacc); W0; W1; PIN(PW); SBAR(); }while(0)
  #define EX(v) __builtin_amdgcn_exp2f(v)
  #define GAPB(MF,X,B) do{ MF; X[B]=EX(X[B]); X[B+1]=EX(X[B+1]); X[B+2]=EX(X[B+2]); X[B+3]=EX(X[B+3]); PIN(X); SBAR(); }while(0)
  #define VRD(i) do{ vlo[i]=vtr(vp_+(((i)>>2)*4096+((i)&3)*1024)); vhi[i]=vtr(vp_+(((i)>>2)*4096+((i)&3)*1024+512)); }while(0)
  #define KRD(G,j) do{ if(G){ kload2(kf,kp0+sl_next,j); SBAR(); } }while(0)
  #define STEP(C0,C1,P0,P1,t,GK,GV,GL) do{ SBAR(); \
    const lds_cptr vp_=vp0+sl_prev; \
    VRD(0); SBAR(); float sacc=(P0[0]+P0[1]); \
    GAPA(C0=__builtin_amdgcn_mfma_f32_32x32x16_bf16(kf[0],qr[0],negm,0,0,0), P0[2],P0[3],P0[4],P0[5],     pw0[0]=PKW(P0,0), pw0[1]=PKW(P0,2), pw0); \
    VRD(4); SBAR(); GAPA(C1=__builtin_amdgcn_mfma_f32_32x32x16_bf16(kf[1],qr[0],negm,0,0,0), P0[6],P0[7],P0[8],P0[9],     pw0[2]=PKW(P0,4), pw0[3]=PKW(P0,6), pw0); \
    VRD(1); SBAR(); GAPA(C0=__builtin_amdgcn_mfma_f32_32x32x16_bf16(kf[2],qr[1],C0,0,0,0),   P0[10],P0[11],P0[12],P0[13], pw1[0]=PKW(P0,8), pw1[1]=PKW(P0,10), pw1); \
    VRD(5); SBAR(); GAPA(C1=__builtin_amdgcn_mfma_f32_32x32x16_bf16(kf[3],qr[1],C1,0,0,0),   P0[14],P0[15],P1[0],P1[1],   pw1[2]=PKW(P0,12),pw1[3]=PKW(P0,14), pw1); \
    VRD(2); SBAR(); GAPA(C0=__builtin_amdgcn_mfma_f32_32x32x16_bf16(kf[4],qr[2],C0,0,0,0),   P1[2],P1[3],P1[4],P1[5],     pw2[0]=PKW(P1,0), pw2[1]=PKW(P1,2), pw2); \
    VRD(6); SBAR(); GAPA(C1=__builtin_amdgcn_mfma_f32_32x32x16_bf16(kf[5],qr[2],C1,0,0,0),   P1[6],P1[7],P1[8],P1[9],     pw2[2]=PKW(P1,4), pw2[3]=PKW(P1,6), pw2); \
    VRD(3); SBAR(); GAPA(C0=__builtin_amdgcn_mfma_f32_32x32x16_bf16(kf[6],qr[3],C0,0,0,0),   P1[10],P1[11],P1[12],P1[13], pw3[0]=PKW(P1,8), pw3[1]=PKW(P1,10), pw3); \
    VRD(7); SBAR(); GAPA(C1=__builtin_amdgcn_mfma_f32_32x32x16_bf16(kf[7],qr[3],C1,0,0,0),   P1[14],P1[15],0.f,0.f,       pw3[2]=PKW(P1,12),pw3[3]=PKW(P1,14), pw3); \
    l_reg+=sacc; \
    if(GK){DMA_K((t)+3,sl_cur);} if(GV){DMA_V((t)+1,sl_next);} \
    FOXBIAS(C0,C1,t); CMASK(C0,C1,t); \
    { float a=MX3(C0[0],C0[1],C1[0]),b=MX3(C0[2],C0[3],C1[1]); a=MX3(a,C1[2],C1[3]); \
      _Pragma("unroll") for(int r=4;r<16;r+=4){a=MX3(a,C0[r],C0[r+1]);b=MX3(b,C0[r+2],C0[r+3]);a=MX3(a,C1[r],C1[r+1]);b=MX3(b,C1[r+2],C1[r+3]);} \
      float rm=__builtin_fmaxf(a,b); { auto rr=__builtin_amdgcn_permlane32_swap(__float_as_uint(rm),__float_as_uint(rm),false,false); rm=__builtin_fmaxf(__uint_as_float(rr[0]),__uint_as_float(rr[1])); } \
      resc=false; \
      if(__builtin_expect(__any(rm>(float)THRL),0)){ const float dl=__builtin_fmaxf(rm,0.f); mhat+=dl; \
        _Pragma("unroll") for(int r=0;r<16;++r){C0[r]-=dl;C1[r]-=dl;} \
        const float f=__builtin_amdgcn_exp2f(-dl); l_reg*=f; if(hi==0)wsf[r32]=f; resc=true; } } \
    SBAR(); \
    GAPB(o[0]=__builtin_amdgcn_mfma_f32_32x32x16_bf16(PAF(0),VFR(0),o[0],0,0,0), C0,0); \
    GAPB(o[1]=__builtin_amdgcn_mfma_f32_32x32x16_bf16(PAF(0),VFR(4),o[1],0,0,0), C0,4); \
    KRD(GL,0); GAPB(o[0]=__builtin_amdgcn_mfma_f32_32x32x16_bf16(PAF(1),VFR(1),o[0],0,0,0), C0,8); \
    KRD(GL,1); GAPB(o[1]=__builtin_amdgcn_mfma_f32_32x32x16_bf16(PAF(1),VFR(5),o[1],0,0,0), C0,12); \
    KRD(GL,2); GAPB(o[0]=__builtin_amdgcn_mfma_f32_32x32x16_bf16(PAF(2),VFR(2),o[0],0,0,0), C1,0); \
    KRD(GL,3); GAPB(o[1]=__builtin_amdgcn_mfma_f32_32x32x16_bf16(PAF(2),VFR(6),o[1],0,0,0), C1,4); \
    GAPB(o[0]=__builtin_amdgcn_mfma_f32_32x32x16_bf16(PAF(3),VFR(3),o[0],0,0,0), C1,8); \
    GAPB(o[1]=__builtin_amdgcn_mfma_f32_32x32x16_bf16(PAF(3),VFR(7),o[1],0,0,0), C1,12); \
    }while(0)
  int t=1;
  #undef CMASK
  #define CMASK(P0,P1,t) do{}while(0)
  for(;t+5<NT;t+=2){
    STEP(pB0,pB1,pA0,pA1,t,true,true,true);     WAIT_BAR(2); RESC(); ROT();
    STEP(pA0,pA1,pB0,pB1,t+1,true,true,true);   WAIT_BAR(2); RESC(); ROT();
  }
  #undef CMASK
  #define CMASK(P0,P1,t) do{int jb_=(t)-(NT-4); if(jb_>=0)cmask(P0,P1,jb_,qrel,hi);}while(0)
  #define ENDW(tt) do{ if((tt)+3<NT){WAIT_BAR(2);} else if((tt)+2<NT){WAIT_BAR(1);} else {WAIT_BAR(0);} }while(0)
  for(;t+1<NT;t+=2){
    STEP(pB0,pB1,pA0,pA1,t,(t+3<NT),(t+1<NT),(t+1<NT));       ENDW(t);   RESC(); ROT();
    STEP(pA0,pA1,pB0,pB1,t+1,(t+4<NT),(t+2<NT),(t+2<NT));     ENDW(t+1); RESC(); ROT();
  }
  STEP(pB0,pB1,pA0,pA1,NT-1,false,false,false); RESC();
  { float sacc=pB0[0]+pB0[1]; _Pragma("unroll") for(int r=2;r<16;++r)sacc+=pB0[r]; _Pragma("unroll") for(int r=0;r<16;++r)sacc+=pB1[r]; l_reg+=sacc;
    pw0=(u32x4){PKW(pB0,0),PKW(pB0,2),PKW(pB0,4),PKW(pB0,6)};pw1=(u32x4){PKW(pB0,8),PKW(pB0,10),PKW(pB0,12),PKW(pB0,14)};pw2=(u32x4){PKW(pB1,0),PKW(pB1,2),PKW(pB1,4),PKW(pB1,6)};pw3=(u32x4){PKW(pB1,8),PKW(pB1,10),PKW(pB1,12),PKW(pB1,14)};
    SBAR(); pv(o,vb0+sl_cur,PAF(0),PAF(1),PAF(2),PAF(3)); }
  #undef PKW
  #undef PAF
  #undef VFR
  #undef PIN
  #undef MX3
  #undef GAPA
  #undef GAPB
  #undef EX
  #undef VRD
  #undef KRD
  #undef STEP
  #undef ENDW
  {auto rr=__builtin_amdgcn_permlane32_swap(__float_as_uint(l_reg),__float_as_uint(l_reg),false,false);l_reg=__uint_as_float(rr[0])+__uint_as_float(rr[1]);}
  if(hi==0)wsf[32+r32]=l_reg;asm volatile("s_waitcnt lgkmcnt(0)":::"memory");
  float rli[16];
  #pragma unroll
  for(int r=0;r<16;++r)rli[r]=__builtin_amdgcn_rcpf(wsf[32+crow(r,hi)]);
  bf16*Ow=O+(rowbase+q0+wid*QBLK)*DM+h*D; const bf16*Gw=Gt+(rowbase+q0+wid*QBLK)*DM+h*D;
  { bf16*stg=(bf16*)(shm+LDS_OST)+wid*2048;
    #pragma unroll
    for(int r=0;r<16;++r){const int orow=crow(r,hi);
      #pragma unroll
      for(int d0=0;d0<2;++d0)stg[orow*64+d0*32+r32]=__float2bfloat16(o[d0][r]*rli[r]);}
    asm volatile("s_waitcnt lgkmcnt(0)":::"memory");
    #pragma unroll
    for(int i=0;i<4;++i){const int row=i*8+(lane>>3),ch=lane&7; u32x4 v=*(const u32x4*)(stg+row*64+ch*8); const u32x4 gq=*(const u32x4*)(Gw+(long)row*DM+ch*8);
      _Pragma("unroll") for(int e=0;e<4;++e){ const unsigned a_=v[e],g_=gq[e]; v[e]=cvtpk_s(__uint_as_float(a_<<16)*__uint_as_float(g_<<16),__uint_as_float(a_&0xffff0000u)*__uint_as_float(g_&0xffff0000u)); }
      ATTN_STORE16(Ow+(long)row*DM+ch*8,v);} }
  asm volatile("s_waitcnt lgkmcnt(0)\n\ts_barrier":::"memory");
  #undef DMA_K
  #undef DMA_V
  #undef CMASK
  #undef START
  #undef RESC
  #undef ROT
}
constexpr int ATTN_LDS_BYTES=LDS_BYTES;
struct AttnTensors { const bf16* Q; const bf16* K; const bf16* V; const bf16* G; bf16* O; };
struct AttnUnit { int bh; int qb; };
struct StaticOrder {
  int vcu;
  __device__ __forceinline__ explicit StaticOrder(int grid,int block):vcu((block%8)*(grid/8)+block/8){}
  __device__ __forceinline__ bool next(int i,AttnUnit&u)const{ if(i>=4)return false; const int s=vcu&7; u.bh=vcu>>3; u.qb=(i==0)?s:(i==1)?15-s:(i==2)?16+s:31-s; return true; }
  __device__ __forceinline__ void a_ready(const AttnUnit&)const{}
  __device__ __forceinline__ void done(const AttnUnit&)const{}
};
template<class Sched,int THRL=8> __device__ __forceinline__ void attn_phase(char*lds,const AttnTensors&T,const Sched&S,lds_cfptr cumL,const __attribute__((address_space(3))) int* t0s){
  AttnUnit u;
  for(int i=0;S.next(i,u);++i){ S.a_ready(u); attn_unit<THRL>(u.bh/NHEAD,u.bh%NHEAD,u.qb,T.Q,T.K,T.V,T.G,T.O,lds,cumL,t0s[i]); S.done(u); }
}
#undef SBAR
#undef WAIT_BAR
}
#define GAS __attribute__((address_space(1)))
#define LAS __attribute__((address_space(3)))
typedef unsigned short bf16;
typedef unsigned v4u __attribute__((ext_vector_type(4)));
typedef float f32x4 __attribute__((ext_vector_type(4)));
typedef short bf16x8 __attribute__((ext_vector_type(8)));
typedef GAS unsigned gu32;
typedef GAS unsigned long long gu64;
#define RLX_AGENT __ATOMIC_RELAXED, __HIP_MEMORY_SCOPE_AGENT
#define LDS_WAIT() asm volatile("s_waitcnt lgkmcnt(0)" ::: "memory")
#define VM_WAIT() asm volatile("s_waitcnt vmcnt(0)" ::: "memory")
__device__ __forceinline__ unsigned long long rt() { return __builtin_amdgcn_s_memrealtime(); }
__device__ __forceinline__ unsigned f2bf(float f) { unsigned u = __builtin_bit_cast(unsigned, f); return (u + 0x7fffu + ((u >> 16) & 1u)) >> 16; }
__device__ __forceinline__ unsigned pk2(float lo, float hi) { return f2bf(lo) | (f2bf(hi) << 16); }

#define XB_TMO      128
#define XB_XCNT(j)  (256  + 64 * (j))
#define XB_XSUB(j)  (1280 + 64 * (j))
#define XB_XGEN(j)  (2304 + 64 * (j))
#define XB_TOP      3328
#define XB_TOPGEN   3392
#define XCD_BAR_WORDS 3456
#define XB_SPIN_CAP (1u << 18)

__device__ __forceinline__ unsigned xb_ld(unsigned* p)              { return __hip_atomic_load(p, __ATOMIC_RELAXED, __HIP_MEMORY_SCOPE_AGENT); }
__device__ __forceinline__ unsigned xb_add(unsigned* p, unsigned v) { return __hip_atomic_fetch_add(p, v, __ATOMIC_RELAXED, __HIP_MEMORY_SCOPE_AGENT); }
__device__ __forceinline__ unsigned xb_xcc_id() { return (unsigned)__builtin_amdgcn_s_getreg((3 << 11) | 20) & 0xFu; }
#define XB_SPIN(cond, bar) do { unsigned _sp = 0; while (cond) { __builtin_amdgcn_s_sleep(1); \
    if ((++_sp & 255u) == 0u) { if (xb_ld(&(bar)[XB_TMO])) break; if (_sp > XB_SPIN_CAP) { atomicAdd(&(bar)[XB_TMO], 1u); break; } } } } while (0)

struct XcdBarrier {
    unsigned* bar; unsigned x;
    volatile LAS unsigned* st;
};

__device__ __forceinline__ XcdBarrier xcd_barrier_post(unsigned* bar, volatile LAS unsigned* st) {
    XcdBarrier b; b.bar = bar; b.x = xb_xcc_id(); b.st = st;
    if (threadIdx.x == 0) (void)xb_add(&bar[XB_XCNT(b.x)], 1u);
    return b;
}
__device__ __forceinline__ void xcd_barrier_complete(unsigned* bar, unsigned x, unsigned& nloc, unsigned& nx) {
    const unsigned G = gridDim.x * gridDim.y * gridDim.z;
    unsigned sum, cnt, mine, sp = 0u;
    for (;;) {
        sum = 0u; cnt = 0u; mine = 0u;
#pragma unroll
        for (unsigned j = 0; j < 16; ++j) { const unsigned c = xb_ld(&bar[XB_XCNT(j)]); sum += c; cnt += (c > 0u) ? 1u : 0u; mine = (j == x) ? c : mine; }
        if (sum == G) break;
        __builtin_amdgcn_s_sleep(1);
        if ((++sp & 255u) == 0u) { if (xb_ld(&bar[XB_TMO])) break; if (sp > XB_SPIN_CAP) { atomicAdd(&bar[XB_TMO], 1u); break; } }
    }
    nloc = mine > 0u ? mine : 1u; nx = cnt > 0u ? cnt : 1u;
}

__device__ __forceinline__ void xcd_barrier(const XcdBarrier& b) {
    asm volatile("s_waitcnt vmcnt(0)" ::: "memory");
    __syncthreads();
    int t0_ = threadIdx.x; asm volatile("" : "+v"(t0_));
    if (t0_ == 0) {
        unsigned* bar = b.bar; unsigned bx_ = b.x; asm volatile("" : "+s"(bx_), "+s"(bar));
        __builtin_amdgcn_s_waitcnt(0);
        unsigned nloc = b.st[0], nx = b.st[1];
        if (nloc == 0u) { xcd_barrier_complete(bar, bx_, nloc, nx); b.st[0] = nloc; b.st[1] = nx; }
        const unsigned old = xb_add(&bar[XB_XSUB(bx_)], 1u);
        const unsigned gen = old / nloc;
        if (old + 1u == (gen + 1u) * nloc) {
            __builtin_amdgcn_fence(__ATOMIC_RELEASE, "agent");
            asm volatile("s_waitcnt vmcnt(0)" ::: "memory");
            const unsigned og = xb_add(&bar[XB_TOP], 1u);
            const unsigned tg = og / nx;
            if (og + 1u == (tg + 1u) * nx) xb_add(&bar[XB_TOPGEN], 1u);
            else XB_SPIN(xb_ld(&bar[XB_TOPGEN]) == tg, bar);
            __builtin_amdgcn_fence(__ATOMIC_ACQUIRE, "agent");
            xb_add(&bar[XB_XGEN(bx_)], 1u);
            asm volatile("s_waitcnt vmcnt(0)" ::: "memory");
        } else {
            XB_SPIN(xb_ld(&bar[XB_XGEN(bx_)]) == gen, bar);
            __builtin_amdgcn_fence(__ATOMIC_ACQUIRE, "agent");
            asm volatile("s_waitcnt vmcnt(0)" ::: "memory");
        }
    }
    __syncthreads();
}
typedef float f32x2 __attribute__((ext_vector_type(2)));
constexpr int NWAVES = 8;
constexpr int BATCH = 2, SEQ = 8192, D = 1024, M = BATCH * SEQ, FF = 2816, NUP = 2 * FF, NADA = 9 * D, FOXLD = 4 * D + 16, DEPTH = 2;
constexpr float EPS = 1e-6f;
constexpr size_t MiB = 1u << 20;
constexpr size_t WS_CTL = 0, CTL_ZERO_BYTES = 1 * MiB;
constexpr size_t WS_MOD = 1 * MiB;
constexpr size_t WS_LB = 1 * MiB + 256 * 1024;
constexpr size_t WS_WUP = 2 * MiB, WUP_BYTES = (size_t)NUP * D * 2;
constexpr size_t WS_WDN = 46 * MiB, WDN_BYTES = (size_t)D * FF * 2;
constexpr size_t WS_WFIN = 68 * MiB, WS_WFOUT = 76 * MiB, WS_WHIN = 78 * MiB, WS_WHOUT = 86 * MiB;
constexpr size_t WS_H = 88 * MiB;
constexpr size_t WS_BIG = 120 * MiB;
constexpr size_t WS_ACT = WS_BIG;
constexpr size_t WS_FQ = WS_BIG, WS_FK = WS_BIG + 32 * MiB, WS_FV = WS_BIG + 64 * MiB, WS_FG = WS_BIG + 96 * MiB, WS_FLF = WS_BIG + 128 * MiB;
constexpr size_t WS_HQ = WS_BIG, WS_HO = WS_BIG + 32 * MiB, WS_HV = WS_BIG + 64 * MiB, WS_HG = WS_BIG + 96 * MiB, WS_HLF = WS_BIG + 128 * MiB, WS_HS = WS_BIG + 192 * MiB, WS_HD = WS_BIG + 208 * MiB;
constexpr size_t WS_END = WS_BIG + 210 * MiB;
constexpr int CW_TMO = 0, CW_CODE = 1, CW_BAR = 4096, CW_STAT = 8192;

constexpr int RING_OFF = 0, RING_BYTES = 131072;
constexpr int LDSCTL_OFF = RING_BYTES, MISC_OFF = LDSCTL_OFF + 320;
constexpr int LDS_BYTES = 147456;
constexpr int ATT_CUM_OFF = 86016;
static_assert(attn_body::ATTN_LDS_BYTES <= ATT_CUM_OFF && ATT_CUM_OFF + SEQ * 4 <= RING_BYTES, "attention LDS map");

struct Frame {
    LAS unsigned char* lds;
    volatile LAS unsigned* MISC;
    gu32* ctl;
    int tid, lane, wave;
    int vcu, G;
};

__device__ __forceinline__ float wave_sum(float v) {
#pragma unroll
    for (int o = 1; o < 64; o <<= 1) v += __shfl_xor(v, o);
    return v;
}
__device__ __forceinline__ float bf2f(unsigned short b) { return __uint_as_float((unsigned)b << 16); }

__device__ __forceinline__ void p0_transpose_item(const float* W, int K, int ld, bf16* WT, int row_off, LAS float* scr, int k0, int n0, int lane) {
#pragma unroll 8
    for (int i = 0; i < 32; ++i) { const int kk = 2 * i + (lane >> 5); scr[kk * 33 + (lane & 31)] = W[(size_t)(k0 + kk) * ld + n0 + (lane & 31)]; }
    LDS_WAIT(); asm volatile("" ::: "memory");
    const int c = lane & 7;
#pragma unroll
    for (int j = 0; j < 4; ++j) { const int n = (lane >> 3) + 8 * j; const LAS float* s = scr + (8 * c) * 33 + n;
        v4u o; o.x = pk2(s[0 * 33], s[1 * 33]); o.y = pk2(s[2 * 33], s[3 * 33]); o.z = pk2(s[4 * 33], s[5 * 33]); o.w = pk2(s[6 * 33], s[7 * 33]);
        *(GAS v4u*)(WT + (size_t)(row_off + n0 + n) * K + k0 + 8 * c) = o; }
    LDS_WAIT(); asm volatile("" ::: "memory");
}

struct Ptrs {
    const float *x, *c, *ada_w, *ada_b, *norm_g, *w_up, *w_dn, *fox_w_in, *fox_b_f, *fox_w_out, *hgrn_w_in, *hgrn_norm_g, *hgrn_w_out, *lb_logits, *final_g;
    float* out; unsigned char* ws;
};

__device__ __forceinline__ void p0_prologue(Frame& F0, const Ptrs& P) {
    Frame F = F0; asm volatile("" : "+v"(F.tid)); F.lane = F.tid & 63;
    float* mod = (float*)(P.ws + WS_MOD);
    for (int it = blockIdx.x; it < DEPTH * (NADA / 256); it += F.G) {
        const int i = it / (NADA / 256), s = it % (NADA / 256);
        LAS float* condl = (LAS float*)(F.lds);
        LAS float* red = (LAS float*)(F.lds + 8192);
        for (int idx = F.tid; idx < BATCH * D; idx += NWAVES * 64) { const float cv = P.c[idx]; condl[idx] = cv / (1.0f + __expf(-cv)); }
        __syncthreads();
        float a0[4] = {0.f, 0.f, 0.f, 0.f}, a1[4] = {0.f, 0.f, 0.f, 0.f};
        const float* Wp = P.ada_w + (size_t)i * D * NADA + (size_t)(F.wave * 128) * NADA + s * 256 + F.lane * 4;
#pragma unroll 8
        for (int k = 0; k < 128; ++k) { const f32x4 w = *(const GAS f32x4*)(Wp + (size_t)k * NADA); const float c0 = condl[F.wave * 128 + k], c1 = condl[D + F.wave * 128 + k];
#pragma unroll
            for (int e = 0; e < 4; ++e) { a0[e] += c0 * w[e]; a1[e] += c1 * w[e]; } }
#pragma unroll
        for (int e = 0; e < 4; ++e) { red[(F.wave * 2 + 0) * 256 + F.lane * 4 + e] = a0[e]; red[(F.wave * 2 + 1) * 256 + F.lane * 4 + e] = a1[e]; }
        __syncthreads();
        { const int b = F.tid >> 8, col = F.tid & 255; float sum = P.ada_b[(size_t)i * NADA + s * 256 + col];
#pragma unroll
          for (int w = 0; w < 8; ++w) sum += red[(w * 2 + b) * 256 + col];
          mod[(size_t)(i * BATCH + b) * NADA + s * 256 + col] = sum; }
        __syncthreads();
    }
    if (blockIdx.x == F.G - 1) { float* lb = (float*)(P.ws + WS_LB);
        for (int cidx = F.tid; cidx < D; cidx += NWAVES * 64) { const float l0 = P.lb_logits[cidx], l1 = P.lb_logits[D + cidx]; lb[cidx] = 1.0f / (1.0f + __expf(l0 - l1)); } }
    LAS float* scr = (LAS float*)(F.lds + RING_OFF + F.wave * 16384);
    const int gw = F.vcu * NWAVES + F.wave, NGW = F.G * NWAVES;
    constexpr int I_UP = (D / 64) * (NUP / 32), I_DN = (FF / 64) * (D / 32), I_IN = (D / 64) * (4 * D / 32), I_OUT = (D / 64) * (D / 32);
    constexpr int NITEMS = 4 * I_UP + 4 * I_DN + 2 * I_IN + 2 * I_OUT;
    for (int it = gw; it < NITEMS; it += NGW) {
        int r = it;
        if (r < 4 * I_UP) { const int w = r / I_UP; r %= I_UP; const int nblk = NUP / 32, kb = r / nblk, nb = r % nblk, n0 = 32 * nb;
            const int np = (n0 < FF) ? n0 : n0 - FF; const int drow = (np / 128) * 256 + (n0 < FF ? 0 : 128) + (np % 128);
            p0_transpose_item(P.w_up + (size_t)w * D * NUP, D, NUP, (bf16*)(P.ws + WS_WUP + w * WUP_BYTES), drow - n0, scr, 64 * kb, n0, F.lane); continue; }
        r -= 4 * I_UP;
        if (r < 4 * I_DN) { const int w = r / I_DN; r %= I_DN; const int nblk = D / 32, kb = r / nblk, nb = r % nblk;
            p0_transpose_item(P.w_dn + (size_t)w * FF * D, FF, D, (bf16*)(P.ws + WS_WDN + w * WDN_BYTES), 0, scr, 64 * kb, 32 * nb, F.lane); continue; }
        r -= 4 * I_DN;
        if (r < I_IN) { const int nblk = 4 * D / 32, kb = r / nblk, nb = r % nblk; p0_transpose_item(P.fox_w_in, D, FOXLD, (bf16*)(P.ws + WS_WFIN), 0, scr, 64 * kb, 32 * nb, F.lane); continue; }
        r -= I_IN;
        if (r < I_IN) { const int nblk = 4 * D / 32, kb = r / nblk, nb = r % nblk; p0_transpose_item(P.hgrn_w_in, D, 4 * D, (bf16*)(P.ws + WS_WHIN), 0, scr, 64 * kb, 32 * nb, F.lane); continue; }
        r -= I_IN;
        if (r < I_OUT) { const int nblk = D / 32, kb = r / nblk, nb = r % nblk; p0_transpose_item(P.fox_w_out, D, D, (bf16*)(P.ws + WS_WFOUT), 0, scr, 64 * kb, 32 * nb, F.lane); continue; }
        r -= I_OUT;
        { const int nblk = D / 32, kb = r / nblk, nb = r % nblk; p0_transpose_item(P.hgrn_w_out, D, D, (bf16*)(P.ws + WS_WHOUT), 0, scr, 64 * kb, 32 * nb, F.lane); }
    }
}

template <bool FOX> __device__ __forceinline__ void norm_pass(Frame& F0, const float* xin, const float* g, const float* modp, bf16* H, const float* w_in, const float* b_f, float* FLF) {
    Frame F = F0; asm volatile("" : "+v"(F.tid)); F.lane = F.tid & 63;
    LAS float* WfT = (LAS float*)(F.lds);
    if (FOX) { for (int idx = F.tid; idx < 16 * D; idx += NWAVES * 64) { const int j = idx >> 10, k = idx & 1023; WfT[idx] = w_in[(size_t)k * FOXLD + 4 * D + j]; } __syncthreads(); }
    const int gw = F.vcu * NWAVES + F.wave, NGW = F.G * NWAVES;
    int m = gw;
    do {
        const int b = m >= SEQ ? 1 : 0;
        const GAS f32x4* xr = (const GAS f32x4*)(xin + (size_t)m * D) + F.lane;
        const GAS f32x4* gr = (const GAS f32x4*)g + F.lane;
        const GAS f32x4* shr = (const GAS f32x4*)(modp + (size_t)b * NADA) + F.lane;
        const GAS f32x4* scr = (const GAS f32x4*)(modp + (size_t)b * NADA + D) + F.lane;
        f32x4 v[4]; float s = 0.f;
#pragma unroll
        for (int j = 0; j < 4; ++j) { v[j] = xr[64 * j]; s += (v[j].x * v[j].x + v[j].y * v[j].y) + (v[j].z * v[j].z + v[j].w * v[j].w); }
        const float rstd = 1.0f / sqrtf(wave_sum(s) * (1.f / D) + EPS);
        GAS unsigned long long* o8 = (GAS unsigned long long*)(H + (size_t)m * D) + F.lane;
#pragma unroll
        for (int j = 0; j < 4; ++j) { const f32x4 gg = gr[64 * j], sh = shr[64 * j], sc = scr[64 * j];
            v[j] = v[j] * rstd * gg * (sc + 1.0f) + sh;
            o8[64 * j] = (unsigned long long)pk2(v[j].x, v[j].y) | ((unsigned long long)pk2(v[j].z, v[j].w) << 32); }
        if (FOX) {
            float acc[16];
#pragma unroll
            for (int h = 0; h < 16; ++h) acc[h] = 0.f;
#pragma unroll
            for (int j = 0; j < 4; ++j) {
#pragma unroll
                for (int h = 0; h < 16; ++h) { const f32x4 w = *(const LAS f32x4*)(WfT + h * D + 256 * j + 4 * F.lane); acc[h] += (v[j].x * w.x + v[j].y * w.y) + (v[j].z * w.z + v[j].w * w.w); }
                asm volatile("" ::: "memory"); }
            const int L = F.lane; float r8[8], r4[4], r2[2], r1;
#pragma unroll
            for (int i = 0; i < 8; ++i) { const bool hb = (L & 32) != 0; const float keep = hb ? acc[i + 8] : acc[i], send = hb ? acc[i] : acc[i + 8]; r8[i] = keep + __shfl_xor(send, 32); }
#pragma unroll
            for (int i = 0; i < 4; ++i) { const bool hb = (L & 16) != 0; const float keep = hb ? r8[i + 4] : r8[i], send = hb ? r8[i] : r8[i + 4]; r4[i] = keep + __shfl_xor(send, 16); }
#pragma unroll
            for (int i = 0; i < 2; ++i) { const bool hb = (L & 8) != 0; const float keep = hb ? r4[i + 2] : r4[i], send = hb ? r4[i] : r4[i + 2]; r2[i] = keep + __shfl_xor(send, 8); }
            { const bool hb = (L & 4) != 0; const float keep = hb ? r2[1] : r2[0], send = hb ? r2[0] : r2[1]; r1 = keep + __shfl_xor(send, 4); }
            r1 += __shfl_xor(r1, 2); r1 += __shfl_xor(r1, 1);
            const int h = (L >> 2) & 15;
            const float z = r1 + b_f[h];
            const float ls = fminf(z, 0.f) - log1pf(__expf(-fabsf(z)));
            if ((L & 3) == 0) FLF[(size_t)(b * 16 + h) * SEQ + (m - b * SEQ)] = ls * 1.4426950408889634f;
        }
        m += NGW;
    } while (m < M);
}

__device__ __forceinline__ void final_norm(Frame& F0, float* xio, const float* g) {
    Frame F = F0; asm volatile("" : "+v"(F.tid)); F.lane = F.tid & 63;
    const int gw = F.vcu * NWAVES + F.wave, NGW = F.G * NWAVES;
    int m = gw;
    do {
        GAS f32x4* xr = (GAS f32x4*)(xio + (size_t)m * D) + F.lane; const GAS f32x4* gr = (const GAS f32x4*)g + F.lane;
        f32x4 v[4]; float s = 0.f;
#pragma unroll
        for (int j = 0; j < 4; ++j) { v[j] = xr[64 * j]; s += (v[j].x * v[j].x + v[j].y * v[j].y) + (v[j].z * v[j].z + v[j].w * v[j].w); }
        const float rstd = 1.0f / sqrtf(wave_sum(s) * (1.f / D) + EPS);
#pragma unroll
        for (int j = 0; j < 4; ++j) xr[64 * j] = v[j] * rstd * gr[64 * j];
        m += NGW;
    } while (m < M);
}

__device__ __forceinline__ void fox_cum_to_lds(Frame& F0, const float* flf_bh, LAS float* cum) {
    Frame F = F0; asm volatile("" : "+v"(F.tid)); F.lane = F.tid & 63;
    LAS float* wsum = cum + SEQ;
    const GAS f32x4* src = (const GAS f32x4*)(flf_bh + 16 * F.tid);
    float p[16];
#pragma unroll
    for (int j = 0; j < 4; ++j) { const f32x4 t = src[j]; p[4 * j] = t.x; p[4 * j + 1] = t.y; p[4 * j + 2] = t.z; p[4 * j + 3] = t.w; }
#pragma unroll
    for (int i = 1; i < 16; ++i) p[i] += p[i - 1];
    float incl = p[15];
#pragma unroll
    for (int o = 1; o < 64; o <<= 1) { const float t = __shfl_up(incl, o); if (F.lane >= o) incl += t; }
    if (F.lane == 63) wsum[F.wave] = incl;
    __syncthreads();
    float off = incl - p[15];
    for (int w = 0; w < F.wave; ++w) off += wsum[w];
#pragma unroll
    for (int j = 0; j < 4; ++j) *(LAS f32x4*)(cum + 16 * F.tid + 4 * j) = (f32x4){p[4 * j] + off, p[4 * j + 1] + off, p[4 * j + 2] + off, p[4 * j + 3] + off};
    __syncthreads();
}
namespace hg {
typedef short v4i16_t __attribute__((ext_vector_type(4))); typedef unsigned u32x2 __attribute__((ext_vector_type(2)));
constexpr int RS = 272;
constexpr int PRS = 80;
constexpr int ORS = 528;
constexpr int L_QS = 0, L_QG = 8704, L_KS = 17408, L_KD = 26112, L_VV = 34816, L_PP = 43520, L_SB = 46080, L_OST = 80896, L_DD = 97792, L_PSUM = 98304, L_END = 100352;
static_assert(L_QG == 32 * RS && L_PP + 32 * PRS == L_SB && L_SB + 128 * RS == L_OST && L_OST + 32 * ORS == L_DD, "hgrn LDS map");

__device__ __forceinline__ bf16x8 frag_rm(LAS unsigned char* lds, int base, int rs, int row, int kk, int fq) {
    return *(const LAS bf16x8*)(lds + base + row * rs + kk * 64 + fq * 16);
}
__device__ __forceinline__ bf16x8 frag_tr(LAS unsigned char* lds, int base, int rs, int kbase, int nbase, int lane) {
    const int g = lane >> 4, q = (lane & 15) >> 2, p = lane & 3;
    LAS unsigned char* a = lds + base + (kbase + 8 * g + q) * rs + (nbase + 4 * p) * 2;
    const v4i16_t lo = __builtin_amdgcn_ds_read_tr16_b64_v4i16((LAS v4i16_t*)a);
    const v4i16_t hi = __builtin_amdgcn_ds_read_tr16_b64_v4i16((LAS v4i16_t*)(a + 4 * rs));
    return (bf16x8){lo[0], lo[1], lo[2], lo[3], hi[0], hi[1], hi[2], hi[3]};
}
__device__ __forceinline__ void st_bf16(LAS unsigned char* lds, int off, float v) { *(LAS unsigned short*)(lds + off) = (unsigned short)f2bf(v); }

template <bool FULL> __device__ __forceinline__ float gen_operands(LAS unsigned char* lds, int tid, size_t row0, int hcol, const bf16* HQ, const float* HLF, const bf16* HV) {
    const int c = tid & 127, part = tid >> 7;
    const float* lfp = HLF + (row0 + part * 8) * D + hcol + c;
    float lf[8]; float ps = 0.f;
#pragma unroll
    for (int i = 0; i < 8; ++i) { lf[i] = lfp[(size_t)i * D]; ps += lf[i]; }
    float qv[8];
    if (FULL) { const bf16* qp = HQ + (row0 + part * 8) * D + hcol + c;
#pragma unroll
        for (int i = 0; i < 8; ++i) qv[i] = bf2f(qp[(size_t)i * D]); }
    { const int r = tid >> 4, ch = tid & 15; const v4u vv = *(const GAS v4u*)(HV + (row0 + r) * D + hcol + ch * 8); *(LAS v4u*)(lds + L_VV + r * RS + ch * 16) = vv; }
    LAS float* psum = (LAS float*)(lds + L_PSUM);
    psum[part * 128 + c] = ps;
    __syncthreads();
    const float p0 = psum[c], p1 = psum[128 + c], p2 = psum[256 + c], p3 = psum[384 + c];
    const float gstart = part == 0 ? 0.f : part == 1 ? p0 : part == 2 ? p0 + p1 : (p0 + p1) + p2;
    const float gmid = p0 + p1, glast = (p0 + p1) + (p2 + p3);
    float G = gstart;
#pragma unroll
    for (int i = 0; i < 8; ++i) { const int t = part * 8 + i; G += lf[i];
        const float k = 1.0f - __expf(lf[i]);
        st_bf16(lds, L_KD + t * RS + c * 2, k * __expf(glast - G));
        if (FULL) { st_bf16(lds, L_KS + t * RS + c * 2, k * __expf(gmid - G)); st_bf16(lds, L_QS + t * RS + c * 2, qv[i] * __expf(G - gmid)); st_bf16(lds, L_QG + t * RS + c * 2, qv[i] * __expf(G)); } }
    if (part == 0) *(LAS float*)(lds + L_DD + c * 4) = __expf(glast);
    __syncthreads();
    return glast;
}
__device__ __forceinline__ void state_update(LAS unsigned char* lds, f32x4 (&st)[8], int w, int lane) {
    const int fr = lane & 15;
    const bf16x8 aV = frag_tr(lds, L_VV, RS, 0, 16 * w, lane);
#pragma unroll
    for (int ct = 0; ct < 8; ++ct) { const float dv = *(const LAS float*)(lds + L_DD + (16 * ct + fr) * 4);
        const bf16x8 bK = frag_tr(lds, L_KD, RS, 0, 16 * ct, lane);
        st[ct] = st[ct] * dv; st[ct] = __builtin_amdgcn_mfma_f32_16x16x32_bf16(aV, bK, st[ct], 0, 0, 0); }
}
__device__ __forceinline__ void write_state_copy(LAS unsigned char* lds, const f32x4 (&st)[8], int w, int lane) {
    const int fr = lane & 15, fq = lane >> 4;
#pragma unroll
    for (int ct = 0; ct < 8; ++ct) { u32x2 pk; pk.x = pk2(st[ct][0], st[ct][1]); pk.y = pk2(st[ct][2], st[ct][3]); *(LAS u32x2*)(lds + L_SB + (16 * ct + fr) * RS + (16 * w + 4 * fq) * 2) = pk; }
}

__device__ __forceinline__ void pass_a(Frame& F0, const float* HLF, const bf16* HV, float* HS, float* HDl) {
    Frame F = F0; asm volatile("" : "+v"(F.tid)); F.lane = F.tid & 63;
    LAS unsigned char* lds = F.lds; const int tid = F.tid, lane = F.lane, w = F.wave;
    for (int unit = F.vcu; unit < 256; unit += F.G) {
        const int bh = unit >> 4, j = unit & 15, b = bh >> 3, h = bh & 7;
        f32x4 st[8];
#pragma unroll
        for (int ct = 0; ct < 8; ++ct) st[ct] = (f32x4){0.f, 0.f, 0.f, 0.f};
        float dlog = 0.f;
#pragma unroll 1
        for (int ch = 0; ch < 16; ++ch) {
            const size_t row0 = (size_t)b * SEQ + j * 512 + ch * 32;
            dlog += gen_operands<false>(lds, tid, row0, h * 128, nullptr, HLF, HV);
            state_update(lds, st, w, lane);
            __syncthreads();
        }
        float* so = HS + (size_t)unit * 16384;
#pragma unroll
        for (int ct = 0; ct < 8; ++ct) *(GAS f32x4*)(so + ((w * 8 + ct) * 64 + lane) * 4) = st[ct];
        if (tid < 128) HDl[unit * 128 + tid] = dlog;
    }
}
__device__ __forceinline__ void combine(Frame& F0, float* HS, const float* HDl) {
    Frame F = F0; asm volatile("" : "+v"(F.tid)); F.lane = F.tid & 63;
    for (int it = F.vcu; it < 256; it += F.G) {
        const int bh = it >> 4, seg = it & 15;
        if (F.tid < 256) { const int e4 = seg * 256 + F.tid, ct = (e4 >> 6) & 7, c = 16 * ct + (e4 & 15);
            f32x4 S = (f32x4){0.f, 0.f, 0.f, 0.f};
#pragma unroll 4
            for (int j = 0; j < 16; ++j) { GAS f32x4* p = (GAS f32x4*)(HS + (size_t)(bh * 16 + j) * 16384) + e4; const f32x4 tmp = *p; const float dv = __expf(HDl[(bh * 16 + j) * 128 + c]); *p = S; S = S * dv + tmp; } }
    }
}
__device__ __forceinline__ void pass_c(Frame& F0, const bf16* HQ, const float* HLF, const bf16* HV, const bf16* HG, const float* HS, const float* gnorm, bf16* HO) {
    Frame F = F0; asm volatile("" : "+v"(F.tid)); F.lane = F.tid & 63;
    LAS unsigned char* lds = F.lds; const int tid = F.tid, lane = F.lane, w = F.wave, fr = lane & 15, fq = lane >> 4;
    for (int unit = F.vcu; unit < 256; unit += F.G) {
        const int bh = unit >> 4, j = unit & 15, b = bh >> 3, h = bh & 7, hcol = h * 128;
        f32x4 st[8];
        { const float* so = HS + (size_t)unit * 16384;
#pragma unroll
          for (int ct = 0; ct < 8; ++ct) st[ct] = *(const GAS f32x4*)(so + ((w * 8 + ct) * 64 + lane) * 4); }
        write_state_copy(lds, st, w, lane);
#pragma unroll 1
        for (int ch = 0; ch < 16; ++ch) {
            const size_t row0 = (size_t)b * SEQ + j * 512 + ch * 32;
            gen_operands<true>(lds, tid, row0, hcol, HQ, HLF, HV);
            if (w < 4) { const int stl = w >> 1, ttl = w & 1; f32x4 x = (f32x4){0.f, 0.f, 0.f, 0.f};
                if (stl <= ttl) {
#pragma unroll
                    for (int kk = 0; kk < 4; ++kk) { const bf16x8 a = frag_rm(lds, L_KS, RS, 16 * stl + fr, kk, fq), bq = frag_rm(lds, L_QS, RS, 16 * ttl + fr, kk, fq); x = __builtin_amdgcn_mfma_f32_16x16x32_bf16(a, bq, x, 0, 0, 0); }
                    const int t = 16 * ttl + fr;
#pragma unroll
                    for (int r = 0; r < 4; ++r) { const int s = 16 * stl + 4 * fq + r; if (s > t) x[r] = 0.f; } }
                u32x2 pk; pk.x = pk2(x[0], x[1]); pk.y = pk2(x[2], x[3]);
                *(LAS u32x2*)(lds + L_PP + (16 * ttl + fr) * PRS + (16 * stl + 4 * fq) * 2) = pk; }
            __syncthreads();
            f32x4 o[2];
            { const bf16x8 bV = frag_tr(lds, L_VV, RS, 0, 16 * w, lane);
              bf16x8 bS[4];
#pragma unroll
              for (int kk = 0; kk < 4; ++kk) bS[kk] = frag_tr(lds, L_SB, RS, 32 * kk, 16 * w, lane);
#pragma unroll
              for (int tt = 0; tt < 2; ++tt) { o[tt] = (f32x4){0.f, 0.f, 0.f, 0.f};
                  const bf16x8 aP = *(const LAS bf16x8*)(lds + L_PP + (16 * tt + fr) * PRS + fq * 16);
                  o[tt] = __builtin_amdgcn_mfma_f32_16x16x32_bf16(aP, bV, o[tt], 0, 0, 0);
#pragma unroll
                  for (int kk = 0; kk < 4; ++kk) { const bf16x8 aQ = frag_rm(lds, L_QG, RS, 16 * tt + fr, kk, fq); o[tt] = __builtin_amdgcn_mfma_f32_16x16x32_bf16(aQ, bS[kk], o[tt], 0, 0, 0); } } }
            state_update(lds, st, w, lane);
#pragma unroll
            for (int tt = 0; tt < 2; ++tt)
#pragma unroll
                for (int r = 0; r < 4; ++r) *(LAS float*)(lds + L_OST + (16 * tt + 4 * fq + r) * ORS + (16 * w + fr) * 4) = o[tt][r];
            __syncthreads();
            write_state_copy(lds, st, w, lane);
#pragma unroll
            for (int rr = 0; rr < 4; ++rr) { const int t = 4 * w + rr; const f32x2 ov = *(const LAS f32x2*)(lds + L_OST + t * ORS + lane * 8);
                const float ss = wave_sum(ov.x * ov.x + ov.y * ov.y); const float rstd = 1.0f / sqrtf(ss * (1.f / 128.f) + EPS);
                const size_t gi = (row0 + t) * D + hcol + 2 * lane; const unsigned gq = *(const GAS unsigned*)(HG + gi);
                const float g0 = gnorm[hcol + 2 * lane], g1 = gnorm[hcol + 2 * lane + 1];
                *(GAS unsigned*)(HO + gi) = pk2(ov.x * rstd * g0 * __uint_as_float(gq << 16), ov.y * rstd * g1 * __uint_as_float(gq & 0xffff0000u)); }
            __syncthreads();
        }
    }
}
}
struct Args { const float* in[15]; float* out; unsigned char* ws; };
#ifndef PHMASK
#define PHMASK 0xffff
#endif
#ifndef PG8_SP2
#define PG8_SP2 true
#endif
__global__ void __launch_bounds__(NWAVES * 64, 2) fwd_megakernel(Args args) {
    extern __shared__ __attribute__((aligned(16))) unsigned char lds[];
    Frame F;
    F.lds = (LAS unsigned char*)lds;
    F.MISC = (volatile LAS unsigned*)(F.lds + MISC_OFF);
    F.tid = threadIdx.x; F.lane = F.tid & 63; F.wave = __builtin_amdgcn_readfirstlane(F.tid >> 6);
    F.G = gridDim.x; { const int bx = blockIdx.x; F.vcu = (F.G % 8 == 0) ? (bx % 8) * (F.G / 8) + bx / 8 : bx; }
    Ptrs P;
    P.x = args.in[0]; P.c = args.in[1]; P.ada_w = args.in[2]; P.ada_b = args.in[3]; P.norm_g = args.in[4]; P.w_up = args.in[5]; P.w_dn = args.in[6]; P.fox_w_in = args.in[7]; P.fox_b_f = args.in[8];
    P.fox_w_out = args.in[9]; P.hgrn_w_in = args.in[10]; P.hgrn_norm_g = args.in[11]; P.hgrn_w_out = args.in[12]; P.lb_logits = args.in[13]; P.final_g = args.in[14]; P.out = args.out; P.ws = args.ws;
    unsigned char* ws = args.ws;
    F.ctl = (gu32*)(ws + WS_CTL);
    for (int u = F.tid; u < (LDS_BYTES - LDSCTL_OFF) / 4; u += NWAVES * 64) ((LAS unsigned*)(F.lds + LDSCTL_OFF))[u] = 0u;
    __syncthreads();
    XcdBarrier bar = xcd_barrier_post((unsigned*)(F.ctl + CW_BAR), F.MISC + 8);
#define GRID_BAR() xcd_barrier(bar)
    float* const mod = (float*)(ws + WS_MOD);
    bf16* const Hb = (bf16*)(ws + WS_H);
    bf16* const ACT = (bf16*)(ws + WS_ACT);
    float* const X = P.out;

    if (PHMASK & 1024) p0_prologue(F, P);
    GRID_BAR();

#pragma unroll 1
    for (int layer = 0; layer < DEPTH; ++layer) {
        const float* modl = mod + (size_t)layer * BATCH * NADA;
#pragma unroll 1
        for (int slot = 0; slot < 2; ++slot) {
            if (slot == 1) {
                const float* modm = modl + 1 * 3 * D;
                if (layer == 0) {
if (PHMASK & 1) {
                    norm_pass<true>(F, X, P.norm_g + (size_t)(layer * 3 + 1) * D, modm, Hb, P.fox_w_in, P.fox_b_f, (float*)(ws + WS_FLF));
}
                    GRID_BAR();
                    { pg8::Gemm g{Hb, (const bf16*)(ws + WS_WFIN), M, 4 * D, D}; pg8::StaticOrder S; S.init(M, 4 * D, F.G, (int)blockIdx.x);
                      pg8::EpiSplit4<0> E{(bf16*)(ws + WS_FQ), (size_t)(16 * MiB), nullptr, nullptr, attn_body::C2, (unsigned*)(ws + WS_CTL) + CW_STAT};
                      if (PHMASK & 16) pg8::gemm_phase<pg8::EpiSplit4<0>, pg8::StaticOrder, true, PG8_SP2>(F.lds + RING_OFF, g, S, E); }
                    GRID_BAR();
                    { const attn_body::StaticOrder S((int)F.G, (int)blockIdx.x);
                      LAS float* cum = (LAS float*)(F.lds + ATT_CUM_OFF);
                      fox_cum_to_lds(F, (const float*)(ws + WS_FLF) + (size_t)(S.vcu >> 3) * SEQ, cum);
                      LAS int* t0s = (LAS int*)(cum + SEQ + 8);
                      int t0_ = F.tid; asm volatile("" : "+v"(t0_));
                      if (t0_ == 0) { gu32* st = F.ctl + CW_STAT + (S.vcu >> 3) * 2;
                          const float qs = __uint_as_float(__hip_atomic_load(st, RLX_AGENT)), ks = __uint_as_float(__hip_atomic_load(st + 1, RLX_AGENT));
                          const float thr = 2.0f * (2.02f * sqrtf(qs * ks)) + 40.0f;
                          for (int i = 0; i < 4; ++i) { attn_body::AttnUnit u; S.next(i, u); int t0 = 4 * u.qb; const float cq = cum[256 * u.qb];
                              while (t0 > 0 && !(cum[64 * t0 - 1] - cq >= thr)) t0 -= 2;
                              t0s[i] = t0; } }
                      __syncthreads();
                      const attn_body::AttnTensors AT{(const attn_body::bf16*)(ws + WS_FQ), (const attn_body::bf16*)(ws + WS_FK), (const attn_body::bf16*)(ws + WS_FV), (const attn_body::bf16*)(ws + WS_FG), (attn_body::bf16*)(ws + WS_FQ)};
if (PHMASK & 2) {
                      attn_body::attn_phase<attn_body::StaticOrder>((char*)lds + RING_OFF, AT, S, (attn_body::lds_cfptr)cum, (const LAS int*)t0s);
}
                    }
                    GRID_BAR();
                    { pg8::Gemm g{(const bf16*)(ws + WS_FQ), (const bf16*)(ws + WS_WFOUT), M, D, D}; pg8::StaticOrder S; S.init(M, D, F.G, (int)blockIdx.x);
                      pg8::EpiResGate E{X, X, D, modm + 2 * D, modm + NADA + 2 * D, 1.0f};
                      if (PHMASK & 128) pg8::gemm_phase<pg8::EpiResGate, pg8::StaticOrder, true, PG8_SP2>(F.lds + RING_OFF, g, S, E); }
                    GRID_BAR();
                } else {
                    norm_pass<false>(F, X, P.norm_g + (size_t)(layer * 3 + 1) * D, modm, Hb, nullptr, nullptr, nullptr);
                    GRID_BAR();
                    { pg8::Gemm g{Hb, (const bf16*)(ws + WS_WHIN), M, 4 * D, D}; pg8::StaticOrder S; S.init(M, 4 * D, F.G, (int)blockIdx.x);
                      pg8::EpiSplit4<1> E{(bf16*)(ws + WS_HQ), (size_t)(16 * MiB), (float*)(ws + WS_HLF), (const float*)(ws + WS_LB), 1.0f, nullptr};
                      if (PHMASK & 32) pg8::gemm_phase<pg8::EpiSplit4<1>, pg8::StaticOrder, true, PG8_SP2>(F.lds + RING_OFF, g, S, E); }
                    GRID_BAR();
if (PHMASK & 4) {
                    hg::pass_a(F, (const float*)(ws + WS_HLF), (const bf16*)(ws + WS_HV), (float*)(ws + WS_HS), (float*)(ws + WS_HD));
}
                    GRID_BAR();
                    hg::combine(F, (float*)(ws + WS_HS), (const float*)(ws + WS_HD));
                    GRID_BAR();
if (PHMASK & 8) {
                    hg::pass_c(F, (const bf16*)(ws + WS_HQ), (const float*)(ws + WS_HLF), (const bf16*)(ws + WS_HV), (const bf16*)(ws + WS_HG), (const float*)(ws + WS_HS), P.hgrn_norm_g, (bf16*)(ws + WS_HO));
}
                    GRID_BAR();
                    { pg8::Gemm g{(const bf16*)(ws + WS_HO), (const bf16*)(ws + WS_WHOUT), M, D, D}; pg8::StaticOrder S; S.init(M, D, F.G, (int)blockIdx.x);
                      pg8::EpiResGate E{X, X, D, modm + 2 * D, modm + NADA + 2 * D, 1.0f};
                      if (PHMASK & 256) pg8::gemm_phase<pg8::EpiResGate, pg8::StaticOrder, true, PG8_SP2>(F.lds + RING_OFF, g, S, E); }
                    GRID_BAR();
                }
            }
            const int sub = slot * 2, wi = layer * 2 + slot;
            const float* modf = modl + (size_t)sub * 3 * D;
            const float* xin = (layer == 0 && slot == 0) ? P.x : X;
            norm_pass<false>(F, xin, P.norm_g + (size_t)(layer * 3 + sub) * D, modf, Hb, nullptr, nullptr, nullptr);
            GRID_BAR();
            { pg8::Gemm g{Hb, (const bf16*)(ws + WS_WUP + wi * WUP_BYTES), M, NUP, D}; pg8::StaticOrder S; S.init(M, NUP, F.G, (int)blockIdx.x);
              pg8::EpiSwiGLU E{ACT, FF};
              if (PHMASK & 64) pg8::gemm_phase<pg8::EpiSwiGLU, pg8::StaticOrder, true, PG8_SP2>(F.lds + RING_OFF, g, S, E); }
            GRID_BAR();
            { pg8::Gemm g{ACT, (const bf16*)(ws + WS_WDN + wi * WDN_BYTES), M, D, FF}; pg8::StaticOrder S; S.init(M, D, F.G, (int)blockIdx.x);
              pg8::EpiResGate E{xin, X, D, modf + 2 * D, modf + NADA + 2 * D, 0.5f};
              if (PHMASK & 512) pg8::gemm_phase<pg8::EpiResGate, pg8::StaticOrder, true, PG8_SP2>(F.lds + RING_OFF, g, S, E); }
            GRID_BAR();
        }
    }
    final_norm(F, X, P.final_g);
}

extern "C" void kernel_launch(void* const* d_in, const int* in_sizes, int n_in, void* d_out, int out_size, void* d_ws, size_t ws_size, hipStream_t stream) {
    static int grid = 0;
    if (grid == 0) {
        if (n_in != 15 || in_sizes[0] != M * D || out_size != M * D || ws_size < WS_END) { fprintf(stderr, "kernel_launch: built for 15 inputs, x and out of %d floats, >= %zu bytes of workspace; got n_in %d, in0 %d, out %d, ws %zu; nothing launched\n", M * D, (size_t)WS_END, n_in, n_in > 0 ? in_sizes[0] : -1, out_size, ws_size); grid = -1; return; }
        int dev = 0, cus = 0, per_cu = 0;
        if (hipGetDevice(&dev) != hipSuccess || hipDeviceGetAttribute(&cus, hipDeviceAttributeMultiprocessorCount, dev) != hipSuccess) { fprintf(stderr, "kernel_launch: hipGetDevice / hipDeviceGetAttribute failed\n"); grid = -1; return; }
        if (hipFuncSetAttribute((const void*)fwd_megakernel, hipFuncAttributeMaxDynamicSharedMemorySize, LDS_BYTES) != hipSuccess) { fprintf(stderr, "kernel_launch: hipFuncSetAttribute failed\n"); grid = -1; return; }
        if (hipOccupancyMaxActiveBlocksPerMultiprocessor(&per_cu, (const void*)fwd_megakernel, NWAVES * 64, LDS_BYTES) != hipSuccess || per_cu < 1)
            fprintf(stderr, "kernel_launch: note: the occupancy query reports %d workgroups per CU\n", per_cu);
        (void)hipGetLastError();
        grid = cus;
        if (grid != 256) fprintf(stderr, "kernel_launch: %d CUs; this kernel's unit maps assume 256\n", grid);
    }
    if (grid < 0) return;
    if (hipMemsetAsync((char*)d_ws + WS_CTL, 0, CTL_ZERO_BYTES, stream) != hipSuccess) { fprintf(stderr, "kernel_launch: hipMemsetAsync failed\n"); return; }
    Args a{};
    for (int i = 0; i < 15; ++i) a.in[i] = (const float*)d_in[i];
    a.out = (float*)d_out; a.ws = (unsigned char*)d_ws;
    hipLaunchKernelGGL(fwd_megakernel, dim3(grid), dim3(NWAVES * 64), LDS_BYTES, stream, a);
    const hipError_t le = hipPeekAtLastError();
    if (le != hipSuccess) fprintf(stderr, "kernel_launch: launch failed: %s\n", hipGetErrorName(le));
}
```
